# Optimizing an MI355X kernel written in HIP

```python
import jax
import jax.numpy as jnp
from jax import lax
import numpy as np

D_MODEL = 1024
BATCH = 2
SEQ = 8192
DEPTH = 4

CHUNK = 64
RWKV_HEADS = 8
RWKV_HEAD_DIM = 64
RWKV_WIDTH = RWKV_HEADS * RWKV_HEAD_DIM
DECAY_RANK = 64
ICLR_RANK = 64
GATE_RANK = 128
VRES_RANK = 32
ATT_HEADS = 8
ATT_HEAD_DIM = 64
ATT_WIDTH = ATT_HEADS * ATT_HEAD_DIM
LEFT_CHUNKS = 8
BAND_CHUNKS = LEFT_CHUNKS + 1
BAND = BAND_CHUNKS * CHUNK
REL_MIN = -(CHUNK - 1)
REL_MAX = 128
N_REL = REL_MAX - REL_MIN + 1
MEM_TOKENS = 256
MEM_HEADS = 4
MEM_HEAD_DIM = 128
MEM_WIDTH = MEM_HEADS * MEM_HEAD_DIM
N_BRANCHES = 3
D_FF = 2816
RMS_EPS = 1e-6
GN_EPS = 64e-5
L2_EPS = 1e-12
NEG_INF = -1e30

RWKV_IN = 3 * RWKV_WIDTH + DECAY_RANK + ICLR_RANK + GATE_RANK
ATT_IN = 3 * ATT_WIDTH
MEM_IN = MEM_WIDTH
D_IN = RWKV_IN + ATT_IN + MEM_IN
RWKV_SPLITS = (RWKV_WIDTH, 2 * RWKV_WIDTH, 3 * RWKV_WIDTH,
               3 * RWKV_WIDTH + DECAY_RANK, 3 * RWKV_WIDTH + DECAY_RANK + ICLR_RANK)

kernel_name = 'hybrid_rwkv7_chunkattn_memory_macaron'


def rms_norm(x, gain):
    xf = x.astype(jnp.float32)
    y = xf * lax.rsqrt(jnp.mean(xf * xf, axis=-1, keepdims=True) + RMS_EPS)
    return (y * gain.astype(jnp.float32)).astype(x.dtype)


def swiglu(x, w_in, w_out):
    gate, up = jnp.split(x @ w_in, 2, axis=-1)
    return (jax.nn.silu(gate) * up) @ w_out


def shift_one(u):
    return jnp.pad(u, ((0, 0), (1, 0), (0, 0)))[:, :-1]


def split_heads(u, n_heads):
    return u.reshape(u.shape[0], u.shape[1], n_heads, -1)


def wkv7_scan(r, w, k, v, kk, b):
    def step(state, inp):
        r_t, w_t, k_t, v_t, kk_t, b_t = inp
        sa = jnp.einsum('bhvk,bhk->bhv', state, kk_t)
        state = (state * w_t[:, :, None, :]
                 - sa[..., None] * b_t[:, :, None, :]
                 + v_t[..., None] * k_t[:, :, None, :])
        return state, jnp.einsum('bhvk,bhk->bhv', state, r_t)
    xs = tuple(jnp.moveaxis(t, 1, 0) for t in (r, w, k, v, kk, b))
    bsz, _, nh, n = r.shape
    s0 = jnp.zeros((bsz, nh, n, n), jnp.float32)
    _, ys = lax.scan(step, s0, xs)
    return jnp.moveaxis(ys, 0, 1)


def rwkv7_time_mix(p, h, mu, w0, decay_b, a0, iclr_b, gate_b, k_k, k_a, r_k, gn_g, gn_b,
                   v_first, v0, vres_a, vres_b, use_vres):
    f32 = jnp.float32
    bsz, seq = p.shape[0], p.shape[1]
    p = p + (shift_one(p) - p) * mu
    r, k, v, xw, xa, xg = jnp.split(p, RWKV_SPLITS, axis=-1)
    w_log = -jax.nn.softplus(-(w0 + jnp.tanh(xw) @ decay_b).astype(f32)) - 0.5
    decay = jnp.exp(-jnp.exp(w_log))
    a = jax.nn.sigmoid((a0 + xa @ iclr_b).astype(f32))
    g = jax.nn.sigmoid(xg) @ gate_b
    if use_vres:
        v = v + (v_first - v) * jax.nn.sigmoid(v0 + (h @ vres_a) @ vres_b)
    else:
        v_first = v
    r, k, v = (t.astype(f32) for t in (r, k, v))
    kk = split_heads(k * k_k, RWKV_HEADS)
    kk = kk / jnp.maximum(jnp.linalg.norm(kk, axis=-1, keepdims=True), L2_EPS)
    k = k * (1.0 + (a - 1.0) * k_a)
    rh = split_heads(r, RWKV_HEADS)
    kh = split_heads(k, RWKV_HEADS)
    vh = split_heads(v, RWKV_HEADS)
    ah = split_heads(a, RWKV_HEADS)
    y = wkv7_scan(rh, split_heads(decay, RWKV_HEADS), kh, vh, kk, kk * ah)
    mean = jnp.mean(y, axis=-1, keepdims=True)
    var = jnp.mean(jnp.square(y - mean), axis=-1, keepdims=True)
    y = ((y - mean) * lax.rsqrt(var + GN_EPS)).reshape(bsz, seq, RWKV_WIDTH) * gn_g + gn_b
    bonus = jnp.sum(rh * kh * r_k, axis=-1, keepdims=True) * vh
    y = (y + bonus.reshape(bsz, seq, RWKV_WIDTH)) * g.astype(f32)
    return y.astype(p.dtype), v_first


def chunk_band(t):
    bsz, seq, nh, dh = t.shape
    nc = seq // CHUNK
    tc = t.reshape(bsz, nc, CHUNK, nh, dh)
    tp = jnp.pad(tc, ((0, 0), (LEFT_CHUNKS, 0), (0, 0), (0, 0), (0, 0)))
    band = jnp.stack([tp[:, j:j + nc] for j in range(BAND_CHUNKS)], axis=2)
    return band.reshape(bsz, nc, BAND, nh, dh)


def chunked_rel_attention(q, k, v, rel_table):
    bsz, seq, nh, dh = q.shape
    nc = seq // CHUNK
    qc = q.reshape(bsz, nc, CHUNK, nh, dh)
    kb = chunk_band(k)
    vb = chunk_band(v)
    scores = jnp.einsum('bnqhd,bnkhd->bnhqk', qc, kb,
                        preferred_element_type=jnp.float32) * (dh ** -0.5)
    q_off = jnp.arange(CHUNK)[:, None]
    k_off = jnp.arange(BAND)[None, :]
    dist = LEFT_CHUNKS * CHUNK + q_off - k_off
    bias = rel_table[:, jnp.clip(dist, REL_MIN, REL_MAX) - REL_MIN]
    key_chunk = jnp.arange(nc)[:, None] - LEFT_CHUNKS + jnp.arange(BAND_CHUNKS)[None, :]
    valid = jnp.repeat(key_chunk >= 0, CHUNK, axis=1)
    scores = scores + bias.astype(jnp.float32)[None, None]
    scores = jnp.where(valid[None, :, None, None, :], scores, NEG_INF)
    probs = jax.nn.softmax(scores, axis=-1).astype(v.dtype)
    out = jnp.einsum('bnhqk,bnkhd->bnqhd', probs, vb)
    return out.reshape(bsz, seq, nh * dh)


def memory_attention(q, mk, mv):
    bsz, seq, nh, dh = q.shape
    scores = jnp.einsum('bshd,bmhd->bhsm', q, mk,
                        preferred_element_type=jnp.float32) * (dh ** -0.5)
    probs = jax.nn.softmax(scores, axis=-1).astype(mv.dtype)
    out = jnp.einsum('bhsm,bmhd->bshd', probs, mv)
    return out.reshape(bsz, seq, nh * dh)


def setup_inputs(seed: int = 0) -> dict:
    key = jax.random.key(seed)
    keys = iter(jax.random.split(key, 48))
    f32 = jnp.float32
    L = DEPTH
    D = D_MODEL

    def nrm(shape, scale):
        return jax.random.normal(next(keys), shape, f32) * scale

    def gain(shape):
        return 1.0 + nrm(shape, 0.02)

    def unif(shape, lo, hi):
        return jax.random.uniform(next(keys), shape, f32, lo, hi)

    return {
        'x': nrm((BATCH, SEQ, D), 1.0),
        'mem': nrm((BATCH, MEM_TOKENS, D), 1.0),
        'norm_ffn1': gain((L, D)),
        'ffn1_w_in': nrm((L, D, 2 * D_FF), D ** -0.5),
        'ffn1_w_out': nrm((L, D_FF, D), D_FF ** -0.5),
        'norm_mix': gain((L, D)),
        'w_in': nrm((L, D, D_IN), D ** -0.5),
        'shift_mu': unif((L, RWKV_IN), 0.0, 1.0),
        'decay_w0': unif((L, RWKV_WIDTH), -3.0, 0.0),
        'decay_lora_b': nrm((L, DECAY_RANK, RWKV_WIDTH), 0.5 * DECAY_RANK ** -0.5),
        'iclr_a0': nrm((L, RWKV_WIDTH), 0.5),
        'iclr_lora_b': nrm((L, ICLR_RANK, RWKV_WIDTH), 0.5 * ICLR_RANK ** -0.5),
        'gate_lora_b': nrm((L, GATE_RANK, RWKV_WIDTH), GATE_RANK ** -0.5),
        'rwkv_k_k': 0.85 + nrm((L, RWKV_WIDTH), 0.05),
        'rwkv_k_a': 1.0 + nrm((L, RWKV_WIDTH), 0.05),
        'rwkv_r_k': nrm((L, RWKV_HEADS, RWKV_HEAD_DIM), 0.1),
        'rwkv_gn_g': gain((L, RWKV_WIDTH)),
        'rwkv_gn_b': nrm((L, RWKV_WIDTH), 0.02),
        'vres_v0': nrm((L - 1, RWKV_WIDTH), 0.5),
        'vres_lora_a': nrm((L - 1, D, VRES_RANK), D ** -0.5),
        'vres_lora_b': nrm((L - 1, VRES_RANK, RWKV_WIDTH), VRES_RANK ** -0.5),
        'att_q_norm': gain((L, ATT_HEAD_DIM)),
        'att_k_norm': gain((L, ATT_HEAD_DIM)),
        'att_rel_bias': nrm((L, ATT_HEADS, N_REL), 0.5),
        'norm_mem': gain((L, D)),
        'mem_w_kv': nrm((L, D, 2 * MEM_WIDTH), D ** -0.5),
        'mem_q_norm': gain((L, MEM_HEAD_DIM)),
        'mem_k_norm': gain((L, MEM_HEAD_DIM)),
        'w_branch_rwkv': nrm((L, RWKV_WIDTH, D), RWKV_WIDTH ** -0.5),
        'w_branch_att': nrm((L, ATT_WIDTH, D), ATT_WIDTH ** -0.5),
        'w_branch_mem': nrm((L, MEM_WIDTH, D), MEM_WIDTH ** -0.5),
        'w_gate': nrm((L, D, N_BRANCHES * D), D ** -0.5),
        'b_gate': nrm((L, N_BRANCHES * D), 0.02),
        'w_out': nrm((L, D, D), D ** -0.5),
        'norm_ffn2': gain((L, D)),
        'ffn2_w_in': nrm((L, D, 2 * D_FF), D ** -0.5),
        'ffn2_w_out': nrm((L, D_FF, D), D_FF ** -0.5),
    }


def reference(x, mem, norm_ffn1, ffn1_w_in, ffn1_w_out, norm_mix, w_in, shift_mu, decay_w0,
              decay_lora_b, iclr_a0, iclr_lora_b, gate_lora_b, rwkv_k_k, rwkv_k_a, rwkv_r_k,
              rwkv_gn_g, rwkv_gn_b, vres_v0, vres_lora_a, vres_lora_b, att_q_norm, att_k_norm,
              att_rel_bias, norm_mem, mem_w_kv, mem_q_norm, mem_k_norm, w_branch_rwkv,
              w_branch_att, w_branch_mem, w_gate, b_gate, w_out, norm_ffn2, ffn2_w_in, ffn2_w_out):
    v_first = None
    for l in range(DEPTH):
        x = x + 0.5 * swiglu(rms_norm(x, norm_ffn1[l]), ffn1_w_in[l], ffn1_w_out[l])

        h = rms_norm(x, norm_mix[l])
        proj = h @ w_in[l]
        p_rwkv = proj[..., :RWKV_IN]
        p_att = proj[..., RWKV_IN:RWKV_IN + ATT_IN]
        p_mem = proj[..., RWKV_IN + ATT_IN:]

        use_vres = l > 0
        li = max(l - 1, 0)
        y_rwkv, v_first = rwkv7_time_mix(
            p_rwkv, h, shift_mu[l], decay_w0[l], decay_lora_b[l], iclr_a0[l], iclr_lora_b[l],
            gate_lora_b[l], rwkv_k_k[l], rwkv_k_a[l], rwkv_r_k[l], rwkv_gn_g[l], rwkv_gn_b[l],
            v_first, vres_v0[li], vres_lora_a[li], vres_lora_b[li], use_vres)

        aq, ak, av = jnp.split(p_att, 3, axis=-1)
        aq = rms_norm(split_heads(aq, ATT_HEADS), att_q_norm[l])
        ak = rms_norm(split_heads(ak, ATT_HEADS), att_k_norm[l])
        av = split_heads(av, ATT_HEADS)
        y_att = chunked_rel_attention(aq, ak, av, att_rel_bias[l])

        mkv = rms_norm(mem, norm_mem[l]) @ mem_w_kv[l]
        mk, mv = jnp.split(mkv, 2, axis=-1)
        mk = rms_norm(split_heads(mk, MEM_HEADS), mem_k_norm[l])
        mv = split_heads(mv, MEM_HEADS)
        mq = rms_norm(split_heads(p_mem, MEM_HEADS), mem_q_norm[l])
        y_mem = memory_attention(mq, mk, mv)

        g_rwkv, g_att, g_mem = jnp.split(jax.nn.sigmoid(h @ w_gate[l] + b_gate[l]), N_BRANCHES, axis=-1)
        merged = (g_rwkv * (y_rwkv @ w_branch_rwkv[l])
                  + g_att * (y_att @ w_branch_att[l])
                  + g_mem * (y_mem @ w_branch_mem[l]))
        x = x + merged @ w_out[l]

        x = x + 0.5 * swiglu(rms_norm(x, norm_ffn2[l]), ffn2_w_in[l], ffn2_w_out[l])
    return x
```

```cpp
#include <hip/hip_runtime.h>
#include <hip/hip_cooperative_groups.h>
#include <cstdio>
#include <cstdint>
namespace cg = cooperative_groups;

#define LAS __attribute__((address_space(3)))
typedef unsigned short bf16_t;
typedef short bf16x8 __attribute__((ext_vector_type(8)));
typedef float f32x4 __attribute__((ext_vector_type(4)));
typedef float f32x2 __attribute__((ext_vector_type(2)));
typedef unsigned u32x4 __attribute__((ext_vector_type(4)));
typedef unsigned u32x2 __attribute__((ext_vector_type(2)));

constexpr int DM = 1024, BATCH = 2, SEQ = 8192, DEPTH = 4, MTOK = BATCH * SEQ;
constexpr int RW = 512, DFF = 2816, DIN = 3840, RWKV_IN = 1792;
constexpr int NREL = 192;
constexpr int COL_AQ = 1792, COL_AK = 2304, COL_AV = 2816, COL_MQ = 3328;
constexpr float LOG2E = 1.4426950408889634f;

constexpr size_t MiB = 1u << 20;
constexpr size_t WS_W1A = 1 * MiB;
constexpr size_t WS_W1B = 12 * MiB;
constexpr size_t WS_WP = 18 * MiB;
constexpr size_t WS_WBR = 32 * MiB;
constexpr size_t WS_WO = 35 * MiB;
constexpr size_t WS_HN = 37 * MiB;
constexpr size_t WS_PROJ = 69 * MiB;
constexpr size_t WS_GATES = 189 * MiB;
constexpr size_t WS_VRA = 285 * MiB;
constexpr size_t WS_R = 287 * MiB, WS_K = 303 * MiB, WS_V = 319 * MiB, WS_G = 335 * MiB;
constexpr size_t WS_KK = 351 * MiB, WS_BB = 367 * MiB, WS_EW = 383 * MiB;
constexpr size_t WS_YRAW = 399 * MiB;
constexpr size_t WS_KN = 431 * MiB, WS_VT = 447 * MiB;
constexpr size_t WS_VFIRST = 463 * MiB;
constexpr size_t WS_MK = 479 * MiB;
constexpr size_t WS_MVT = 481 * MiB;
constexpr size_t WS_LIN = 483 * MiB;
constexpr size_t WS_LBT = 495 * MiB;
constexpr size_t WS_END = 495 * MiB + 1536 * 1024;
constexpr size_t WS_SQ = 483 * MiB;
constexpr size_t WS_SMID = 128 * 1024;
constexpr size_t WS_LOA = 37 * MiB;
constexpr size_t WS_LOB = 399 * MiB;
constexpr size_t WS_MERGEDF = WS_KK;
constexpr size_t WS_MERGEDB = WS_R;
constexpr size_t WS_YATT = WS_HN, WS_YMEM = WS_HN + 16 * MiB, WS_YRWKV = WS_HN + 32 * MiB;
constexpr size_t WS_WMKV = WS_GATES;
constexpr size_t WS_MEMN = WS_GATES + 8 * MiB;
constexpr size_t WS_MKVRAW = WS_GATES + 12 * MiB;

constexpr int PTAB_OFF = 155648;
constexpr int LDS_BYTES = PTAB_OFF + 1024;
#define STOP_AT 0
#define DBG_A (WS_GATES + 40 * MiB)
#define DBG_B 0
#ifndef STOP_AT
#define STOP_AT 0
#endif
#ifndef STOP_LAYER
#define STOP_LAYER 0
#endif

struct Args { const float* in[37]; float* out; unsigned char* ws; };

typedef __bf16 bf16x2_t __attribute__((ext_vector_type(2)));
__device__ __forceinline__ unsigned pk2(float lo, float hi) { f32x2 v = {lo, hi}; bf16x2_t b = __builtin_convertvector(v, bf16x2_t); return __builtin_bit_cast(unsigned, b); }
__device__ __forceinline__ unsigned f2bf(float f) { return pk2(f, 0.f) & 0xffffu; }
__device__ __forceinline__ float bf2f(unsigned short b) { return __builtin_bit_cast(float, (unsigned)b << 16); }
__device__ __forceinline__ float bflo(unsigned w) { return __builtin_bit_cast(float, w << 16); }
__device__ __forceinline__ float bfhi(unsigned w) { return __builtin_bit_cast(float, w & 0xffff0000u); }
__device__ __forceinline__ float shx(float v, int o, int lane) { return __builtin_bit_cast(float, __builtin_amdgcn_ds_bpermute((lane ^ o) << 2, __builtin_bit_cast(int, v))); }
__device__ __forceinline__ float wave_sum(float v, int lane);
__device__ __forceinline__ float fexp2(float x) { return __builtin_amdgcn_exp2f(x); }
__device__ __forceinline__ float frcp(float x) { return __builtin_amdgcn_rcpf(x); }
__device__ __forceinline__ float sigmoidf_(float x) { return frcp(1.f + fexp2(-LOG2E * x)); }
#define LDS_WAIT() asm volatile("s_waitcnt lgkmcnt(0)" ::: "memory")
template <int CTRL> __device__ __forceinline__ float dppf(float x) { return __builtin_bit_cast(float, __builtin_amdgcn_update_dpp(0, __builtin_bit_cast(int, x), CTRL, 0xF, 0xF, true)); }
__device__ __forceinline__ float row16_sum(float x) { x += dppf<0xB1>(x); x += dppf<0x4E>(x); x += dppf<0x124>(x); x += dppf<0x128>(x); return x; }
__device__ __forceinline__ float wave_sum(float v, int lane) { v = row16_sum(v); v += shx(v, 16, lane); v += shx(v, 32, lane); return v; }


namespace pg8 {
constexpr int BM = 256, BK = 64, HALF = 128, HTB = HALF * BK * 2, STAGE_BYTES = 8 * HTB, NXCD = 8, WGM = 8;
__host__ __device__ __forceinline__ int lds_byte(int r, int c) { const int st = (r >> 4) * 2 + (c >> 5), rr = r & 15, cc = c & 31, ob = rr * 64 + cc * 2; return st * 1024 + (ob ^ (((ob >> 9) & 1) << 5)); }
__host__ __device__ __forceinline__ void stage_rc(int b, int& R, int& C) { const int st = b / 1024, sb = b % 1024, swz = sb ^ (((sb >> 9) & 1) << 5); R = (st >> 1) * 16 + swz / 64; C = (st & 1) * 32 + (swz % 64) / 2; }
__host__ __device__ __forceinline__ int perm32(int rho) { const int n = rho >> 4, i = rho & 15; return 8 * (i >> 2) + 4 * n + (i & 3); }

struct Unit { int pm, pn, z; };
struct Gemm { const bf16_t* A; const bf16_t* Bt; size_t zA, zB; int M, N, K; };

struct StaticOrder {
    int nM, nN, nwg, G, c, nz;
    __device__ void init(int M, int N, int G_, int c_, int nz_ = 1) { nM = M / BM; nN = N / BM; nwg = nM * nN; G = G_; c = c_; nz = nz_; }
    __device__ bool next(int i, Unit& u) const {
        const int ib = i / nz; u.z = i - ib * nz;
        const long L = (long)ib * G + c; if (c < 0 || L >= nwg) return false;
        int wgid = (int)L; { const int q = nwg / NXCD, r = nwg % NXCD, xcd = wgid % NXCD, off = wgid / NXCD; wgid = (xcd < r ? xcd * (q + 1) : r * (q + 1) + (xcd - r) * q) + off; }
        const int nig = WGM * nN, gid = wgid / nig, fm = gid * WGM, gsz = (nM - fm) < WGM ? (nM - fm) : WGM;
        u.pm = fm + ((wgid % nig) % gsz); u.pn = (wgid % nig) / gsz; return true;
    }
};
struct ZOrder {
    int G, c;
    __device__ bool next(int i, Unit& u) const { const long L = (long)i * G + c; if (L >= 32) return false; u.z = (int)L >> 3; u.pm = ((int)L & 7) >> 2; u.pn = (int)L & 3; return true; }
};

__device__ __forceinline__ unsigned cvt_pk_bf16(float lo, float hi) { return pk2(lo, hi); }


struct EpiSwiglu {
    static constexpr bool PERM = true;
    bf16_t* O;
    __device__ __forceinline__ void operator()(const f32x4 (&acc)[2][2][4][2], const Unit& u, int wr, int wc, int fr, int fq) const {
        const int row0 = u.pm * BM + wr * 64 + fr, col0 = u.pn * 128 + wc * 32 + 8 * fq;
#pragma unroll
        for (int ai = 0; ai < 2; ++ai)
#pragma unroll
            for (int m = 0; m < 4; ++m) {
                bf16_t* p = O + (size_t)(row0 + ai * HALF + m * 16) * DFF + col0;
                float o[8];
#pragma unroll
                for (int n = 0; n < 2; ++n)
#pragma unroll
                    for (int i = 0; i < 4; ++i) { const float g = acc[ai][0][m][n][i], up = acc[ai][1][m][n][i]; o[n * 4 + i] = g * frcp(1.f + fexp2(-LOG2E * g)) * up; }
                u32x4 w; w.x = cvt_pk_bf16(o[0], o[1]); w.y = cvt_pk_bf16(o[2], o[3]); w.z = cvt_pk_bf16(o[4], o[5]); w.w = cvt_pk_bf16(o[6], o[7]);
                *(u32x4*)p = w;
            }
    }
};
struct EpiResid {
    static constexpr bool PERM = false;
    float* X; float s;
    __device__ __forceinline__ void operator()(const f32x4 (&acc)[2][2][4][2], const Unit& u, int wr, int wc, int fr, int fq) const {
        const int row0 = u.pm * BM + wr * 64 + fr, col0 = u.pn * BM + wc * 32 + 4 * fq;
#pragma unroll
        for (int ai = 0; ai < 2; ++ai) {
            f32x4 xv[4][2][2];
#pragma unroll
            for (int m = 0; m < 4; ++m)
#pragma unroll
                for (int bj = 0; bj < 2; ++bj)
#pragma unroll
                    for (int n = 0; n < 2; ++n) xv[m][bj][n] = *(const f32x4*)(X + (size_t)(row0 + ai * HALF + m * 16) * DM + col0 + bj * HALF + n * 16);
            asm volatile("" ::: "memory");
#pragma unroll
            for (int m = 0; m < 4; ++m)
#pragma unroll
                for (int bj = 0; bj < 2; ++bj)
#pragma unroll
                    for (int n = 0; n < 2; ++n) *(f32x4*)(X + (size_t)(row0 + ai * HALF + m * 16) * DM + col0 + bj * HALF + n * 16) = xv[m][bj][n] + acc[ai][bj][m][n] * s;
            asm volatile("" ::: "memory");
        }
    }
};
struct EpiProj {
    static constexpr bool PERM = true;
    bf16_t* P; bf16_t* G; float* VRA; const float* bgate;
    __device__ __forceinline__ void operator()(const f32x4 (&acc)[2][2][4][2], const Unit& u, int wr, int wc, int fr, int fq) const {
        const int row0 = u.pm * BM + wr * 64 + fr;
        if (u.pn < 15) {
            const int col0 = u.pn * BM + wc * 32 + 8 * fq;
#pragma unroll
            for (int ai = 0; ai < 2; ++ai)
#pragma unroll
                for (int m = 0; m < 4; ++m) { bf16_t* rp = P + (size_t)(row0 + ai * HALF + m * 16) * DIN + col0;
#pragma unroll
                    for (int bj = 0; bj < 2; ++bj) { const f32x4 v0 = acc[ai][bj][m][0], v1 = acc[ai][bj][m][1];
                        u32x4 w; w.x = cvt_pk_bf16(v0[0], v0[1]); w.y = cvt_pk_bf16(v0[2], v0[3]); w.z = cvt_pk_bf16(v1[0], v1[1]); w.w = cvt_pk_bf16(v1[2], v1[3]);
                        *(u32x4*)(rp + bj * HALF) = w; } }
        } else if (u.pn < 27) {
            const int col0 = (u.pn - 15) * BM + wc * 32 + 8 * fq;
            f32x4 bv[2][2];
#pragma unroll
            for (int bj = 0; bj < 2; ++bj)
#pragma unroll
                for (int n = 0; n < 2; ++n) bv[bj][n] = *(const f32x4*)(bgate + col0 + bj * HALF + 4 * n);
#pragma unroll
            for (int ai = 0; ai < 2; ++ai)
#pragma unroll
                for (int m = 0; m < 4; ++m) { bf16_t* rp = G + (size_t)(row0 + ai * HALF + m * 16) * 3072 + col0;
#pragma unroll
                    for (int bj = 0; bj < 2; ++bj) { f32x4 v0 = acc[ai][bj][m][0] + bv[bj][0], v1 = acc[ai][bj][m][1] + bv[bj][1];
#pragma unroll
                        for (int i = 0; i < 4; ++i) { v0[i] = sigmoidf_(v0[i]); v1[i] = sigmoidf_(v1[i]); }
                        u32x4 w; w.x = cvt_pk_bf16(v0[0], v0[1]); w.y = cvt_pk_bf16(v0[2], v0[3]); w.z = cvt_pk_bf16(v1[0], v1[1]); w.w = cvt_pk_bf16(v1[2], v1[3]);
                        *(u32x4*)(rp + bj * HALF) = w; } }
        } else {
            if (wc == 0) {
#pragma unroll
                for (int ai = 0; ai < 2; ++ai)
#pragma unroll
                    for (int m = 0; m < 4; ++m) { float* rp = VRA + (size_t)(row0 + ai * HALF + m * 16) * 32 + 8 * fq;
                        *(f32x4*)rp = acc[ai][0][m][0]; *(f32x4*)(rp + 4) = acc[ai][0][m][1]; }
            }
        }
    }
};
struct EpiMerge {
    static constexpr bool PERM = true;
    bf16_t* Mp; bf16_t* Mb; const bf16_t* G;
    __device__ __forceinline__ void operator()(const f32x4 (&acc)[2][2][4][2], const Unit& u, int wr, int wc, int fr, int fq) const {
        const int row0 = u.pm * BM + wr * 64 + fr, col0 = u.pn * BM + wc * 32 + 8 * fq;
        const int z = u.z, goff = (z == 2 ? 0 : (z + 1) * 1024);
        bf16_t* dst = (z == 2) ? Mb : Mp;
#pragma unroll
        for (int ai = 0; ai < 2; ++ai) {
            u32x4 gv[4][2], pv[4][2];
#pragma unroll
            for (int m = 0; m < 4; ++m)
#pragma unroll
                for (int bj = 0; bj < 2; ++bj) { const size_t row = (size_t)(row0 + ai * HALF + m * 16); const int c = col0 + bj * HALF;
                    gv[m][bj] = *(const u32x4*)(G + row * 3072 + goff + c);
                    pv[m][bj] = (z != 0) ? *(const u32x4*)(Mp + row * DM + c) : (u32x4){0u, 0u, 0u, 0u}; }
            asm volatile("" ::: "memory");
#pragma unroll
            for (int m = 0; m < 4; ++m)
#pragma unroll
                for (int bj = 0; bj < 2; ++bj) { const size_t row = (size_t)(row0 + ai * HALF + m * 16); const int c = col0 + bj * HALF;
                    const u32x4 g4 = gv[m][bj], p4 = pv[m][bj];
                    f32x4 v0 = acc[ai][bj][m][0], v1 = acc[ai][bj][m][1];
                    v0[0] = v0[0] * bflo(g4.x) + bflo(p4.x); v0[1] = v0[1] * bfhi(g4.x) + bfhi(p4.x); v0[2] = v0[2] * bflo(g4.y) + bflo(p4.y); v0[3] = v0[3] * bfhi(g4.y) + bfhi(p4.y);
                    v1[0] = v1[0] * bflo(g4.z) + bflo(p4.z); v1[1] = v1[1] * bfhi(g4.z) + bfhi(p4.z); v1[2] = v1[2] * bflo(g4.w) + bflo(p4.w); v1[3] = v1[3] * bfhi(g4.w) + bfhi(p4.w);
                    u32x4 w; w.x = cvt_pk_bf16(v0[0], v0[1]); w.y = cvt_pk_bf16(v0[2], v0[3]); w.z = cvt_pk_bf16(v1[0], v1[1]); w.w = cvt_pk_bf16(v1[2], v1[3]);
                    *(u32x4*)(dst + row * DM + c) = w; }
            asm volatile("" ::: "memory");
        }
    }
};
struct EpiPlain {
    static constexpr bool PERM = true;
    bf16_t* O; int ldc; size_t zO;
    __device__ __forceinline__ void operator()(const f32x4 (&acc)[2][2][4][2], const Unit& u, int wr, int wc, int fr, int fq) const {
        const int row0 = u.pm * BM + wr * 64 + fr, col0 = u.pn * BM + wc * 32 + 8 * fq;
        bf16_t* base = O + (size_t)u.z * zO;
#pragma unroll
        for (int ai = 0; ai < 2; ++ai)
#pragma unroll
            for (int m = 0; m < 4; ++m) { bf16_t* rp = base + (size_t)(row0 + ai * HALF + m * 16) * ldc + col0;
#pragma unroll
                for (int bj = 0; bj < 2; ++bj) { const f32x4 v0 = acc[ai][bj][m][0], v1 = acc[ai][bj][m][1];
                    u32x4 w; w.x = cvt_pk_bf16(v0[0], v0[1]); w.y = cvt_pk_bf16(v0[2], v0[3]); w.z = cvt_pk_bf16(v1[0], v1[1]); w.w = cvt_pk_bf16(v1[2], v1[3]);
                    *(u32x4*)(rp + bj * HALF) = w; } }
    }
};

struct EpiSplit2 {
    static constexpr bool PERM = true;
    bf16_t* O0; bf16_t* O1;
    __device__ __forceinline__ void operator()(const f32x4 (&acc)[2][2][4][2], const Unit& u, int wr, int wc, int fr, int fq) const {
        const int row0 = u.pm * BM + wr * 64 + fr, col0 = (u.pn & 3) * BM + wc * 32 + 8 * fq;
        bf16_t* base = (u.pn < 4) ? O0 : O1;
#pragma unroll
        for (int ai = 0; ai < 2; ++ai)
#pragma unroll
            for (int m = 0; m < 4; ++m) { bf16_t* rp = base + (size_t)(row0 + ai * HALF + m * 16) * 1024 + col0;
#pragma unroll
                for (int bj = 0; bj < 2; ++bj) { const f32x4 v0 = acc[ai][bj][m][0], v1 = acc[ai][bj][m][1];
                    u32x4 w; w.x = cvt_pk_bf16(v0[0], v0[1]); w.y = cvt_pk_bf16(v0[2], v0[3]); w.z = cvt_pk_bf16(v1[0], v1[1]); w.w = cvt_pk_bf16(v1[2], v1[3]);
                    *(u32x4*)(rp + bj * HALF) = w; } }
    }
};
template <class Epi, class Sched>
__device__ __forceinline__ void gemm_phase(LAS unsigned char* lds, const Gemm g, const Sched& S, const Epi& E) {
    int tid_ = threadIdx.x; asm volatile("" : "+v"(tid_));
    const int tid = tid_, wid = __builtin_amdgcn_readfirstlane(tid >> 6), lane = tid & 63, wr = wid >> 2, wc = wid & 3, fr = lane & 15, fq = lane >> 4;
    int K_ = g.K; asm volatile("" : "+s"(K_));
    const int K = K_, nt = K / BK;
    unsigned voffA[2], voffB[2];
#pragma unroll
    for (int i = 0; i < 2; ++i) { int R, C; stage_rc(tid * 16 + i * 8192, R, C); const int Rb = Epi::PERM ? ((R & ~31) + perm32(R & 31)) : R;
        voffA[i] = (unsigned)(R * K + C) * 2u; voffB[i] = (unsigned)(Rb * K + C) * 2u; }
    const size_t kstep = (size_t)(BK * 2);
    const size_t hstep = (size_t)HALF * K * 2;
    const size_t tstep = 2 * hstep;
    const unsigned ldsw = (unsigned)wid * 1024u;
    const int aoff = lds_byte(wr * 64 + fr, fq * 8), boff = lds_byte(wc * 32 + fr, fq * 8);
#define PG8_SA(b, h) (((b) * 2 + (h)) * HTB)
#define PG8_SB(b, h) ((4 + (b) * 2 + (h)) * HTB)
#define PG8_STAGE(bufoff, gbase, voff) do { _Pragma("unroll") for (int _i = 0; _i < 2; ++_i) \
        __builtin_amdgcn_global_load_lds((const unsigned*)((const char*)(gbase) + (voff)[_i]), (LAS unsigned*)(lds + (bufoff) + ldsw + _i * 8192), 16, 0, 0); } while (0)
#define PG8_LDA(dst, b, h) do { _Pragma("unroll") for (int m = 0; m < 4; ++m) _Pragma("unroll") for (int k = 0; k < 2; ++k) dst[m][k] = *(const LAS bf16x8*)(lds + PG8_SA(b, h) + aoff + m * 2048 + k * 1024); } while (0)
#define PG8_LDB(dst, b, h) do { _Pragma("unroll") for (int n = 0; n < 2; ++n) _Pragma("unroll") for (int k = 0; k < 2; ++k) dst[n][k] = *(const LAS bf16x8*)(lds + PG8_SB(b, h) + boff + n * 2048 + k * 1024); } while (0)
#define PG8_MMA(ai, bj, At, Bt) do { __builtin_amdgcn_s_setprio(1); _Pragma("unroll") for (int m = 0; m < 4; ++m) _Pragma("unroll") for (int n = 0; n < 2; ++n) _Pragma("unroll") for (int k = 0; k < 2; ++k) \
        acc[ai][bj][m][n] = __builtin_amdgcn_mfma_f32_16x16x32_bf16(Bt[n][k], At[m][k], acc[ai][bj][m][n], 0, 0, 0); __builtin_amdgcn_s_setprio(0); } while (0)
#define PG8_WAIT_V(n) asm volatile("s_waitcnt vmcnt(" #n ")" ::: "memory")
#define PG8_WAIT_L(n) asm volatile("s_waitcnt lgkmcnt(" #n ")" ::: "memory")
#define PG8_BAR __builtin_amdgcn_s_barrier()
#define PG8_SCHED __builtin_amdgcn_sched_barrier(0)
    Unit cur, nxt; int ui = 0;
    if (S.next(0, cur)) {
    f32x4 acc[2][2][4][2];
#pragma unroll
    for (int a = 0; a < 2; ++a)
#pragma unroll
        for (int b = 0; b < 2; ++b)
#pragma unroll
            for (int m = 0; m < 4; ++m)
#pragma unroll
                for (int n = 0; n < 2; ++n) acc[a][b][m][n] = (f32x4){0.f, 0.f, 0.f, 0.f};
    bf16x8 At[4][2], B0[2][2], B1[2][2];
    const char* cA = (const char*)g.A + (size_t)cur.z * g.zA + (size_t)cur.pm * tstep; const char* cB = (const char*)g.Bt + (size_t)cur.z * g.zB + (size_t)cur.pn * tstep;
    PG8_STAGE(PG8_SB(0, 0), cB, voffB); PG8_STAGE(PG8_SB(0, 1), cB + hstep, voffB); PG8_STAGE(PG8_SA(0, 0), cA, voffA); PG8_STAGE(PG8_SA(0, 1), cA + hstep, voffA);
    if (wr == 1) PG8_BAR;
    PG8_WAIT_V(2); PG8_BAR;
    PG8_STAGE(PG8_SB(1, 0), cB + kstep, voffB); PG8_STAGE(PG8_SA(1, 0), cA + kstep, voffA); PG8_STAGE(PG8_SB(1, 1), cB + hstep + kstep, voffB);
    PG8_WAIT_V(6); PG8_BAR;
    for (;;) {
        const bool has_next = S.next(ui + 1, nxt);
        const char* nA = has_next ? (const char*)g.A + (size_t)nxt.z * g.zA + (size_t)nxt.pm * tstep : cA; const char* nB = has_next ? (const char*)g.Bt + (size_t)nxt.z * g.zB + (size_t)nxt.pn * tstep : cB;
        for (int t = 0; t < nt; t += 2) {
            const bool last = (t == nt - 2);
            const char* a1 = cA + (size_t)(t + 1) * kstep;
            const char* a2 = last ? nA : cA + (size_t)(t + 2) * kstep; const char* b2 = last ? nB : cB + (size_t)(t + 2) * kstep;
            const char* a3 = a2 + kstep; const char* b3 = b2 + kstep;
            PG8_LDB(B0, 0, 0); PG8_LDB(B1, 0, 1); PG8_SCHED; PG8_LDA(At, 0, 0); PG8_STAGE(PG8_SA(1, 1), a1 + hstep, voffA);
            PG8_WAIT_V(8); PG8_WAIT_L(0); PG8_BAR; PG8_MMA(0, 0, At, B0); PG8_MMA(0, 1, At, B1); PG8_BAR; PG8_SCHED;
            PG8_LDA(At, 0, 1); PG8_STAGE(PG8_SB(0, 0), b2, voffB); PG8_STAGE(PG8_SB(0, 1), b2 + hstep, voffB); PG8_STAGE(PG8_SA(0, 0), a2, voffA);
            PG8_WAIT_V(8); PG8_WAIT_L(0); PG8_BAR; PG8_MMA(1, 0, At, B0); PG8_MMA(1, 1, At, B1); PG8_BAR; PG8_SCHED;
            PG8_LDB(B0, 1, 0); PG8_LDB(B1, 1, 1); PG8_SCHED; PG8_LDA(At, 1, 0); PG8_STAGE(PG8_SA(0, 1), a2 + hstep, voffA);
            PG8_WAIT_V(8); PG8_WAIT_L(0); PG8_BAR; PG8_MMA(0, 0, At, B0); PG8_MMA(0, 1, At, B1); PG8_BAR; PG8_SCHED;
            PG8_LDA(At, 1, 1); PG8_STAGE(PG8_SB(1, 0), b3, voffB); PG8_STAGE(PG8_SB(1, 1), b3 + hstep, voffB); PG8_STAGE(PG8_SA(1, 0), a3, voffA);
            PG8_WAIT_V(8); PG8_WAIT_L(0); PG8_BAR; PG8_MMA(1, 0, At, B0); PG8_MMA(1, 1, At, B1); PG8_BAR; PG8_SCHED;
        }
        if (wr == 0) PG8_BAR;
        E(acc, cur, wr, wc, fr, fq);
        if (!has_next) break;
#pragma unroll
        for (int a = 0; a < 2; ++a)
#pragma unroll
            for (int b = 0; b < 2; ++b)
#pragma unroll
                for (int m = 0; m < 4; ++m)
#pragma unroll
                    for (int n = 0; n < 2; ++n) acc[a][b][m][n] = (f32x4){0.f, 0.f, 0.f, 0.f};
        cur = nxt; cA = nA; cB = nB; ++ui;
        if (wr == 1) PG8_BAR;
    }
    PG8_WAIT_V(0);
    PG8_BAR;
    }
#undef PG8_SA
#undef PG8_SB
#undef PG8_STAGE
#undef PG8_LDA
#undef PG8_LDB
#undef PG8_MMA
#undef PG8_WAIT_V
#undef PG8_WAIT_L
#undef PG8_BAR
#undef PG8_SCHED
}
}

__device__ __forceinline__ void tr_item(const float* __restrict__ W, int K, int N, bf16_t* WT, int mode, int row_off, LAS float* scr, int item, int lane) {
    const int nblk = N / 32, kb = item / nblk, nb = item - kb * nblk, k0 = 64 * kb, n0 = 32 * nb;
#pragma unroll 8
    for (int i = 0; i < 32; ++i) { const int kk = 2 * i + (lane >> 5); scr[kk * 33 + (lane & 31)] = W[(size_t)(k0 + kk) * N + n0 + (lane & 31)]; }
    LDS_WAIT(); asm volatile("" ::: "memory");
    int d0;
    if (mode == 1) { const int j = n0 < DFF ? n0 : n0 - DFF; d0 = 256 * (j >> 7) + (j & 127) + (n0 < DFF ? 0 : 128); }
    else d0 = row_off + n0;
    const int c = lane & 7;
#pragma unroll
    for (int j = 0; j < 4; ++j) { const int n = (lane >> 3) + 8 * j; const LAS float* s = scr + (8 * c) * 33 + n;
        u32x4 o; o.x = pk2(s[0 * 33], s[1 * 33]); o.y = pk2(s[2 * 33], s[3 * 33]); o.z = pk2(s[4 * 33], s[5 * 33]); o.w = pk2(s[6 * 33], s[7 * 33]);
        *(u32x4*)(WT + (size_t)(d0 + n) * K + k0 + 8 * c) = o; }
    LDS_WAIT(); asm volatile("" ::: "memory");
}
__device__ __forceinline__ void tr_job(const float* W, bf16_t* WT, int K, int N, int mode, int row_off, int& base, LAS float* scr, int gw, int NGW, int lane) {
    const int items = (K / 64) * (N / 32);
    int first = gw - (base % NGW); if (first < 0) first += NGW;
    for (int it = first; it < items; it += NGW) tr_item(W, K, N, WT, mode, row_off, scr, it, lane);
    base += items;
}

__device__ __forceinline__ void rms_rows(const float* X, float* Xcopy, const float* gain, bf16_t* out, int nrows, int gw, int NGW, int lane) {
    f32x4 gv[4];
#pragma unroll
    for (int j = 0; j < 4; ++j) gv[j] = *(const f32x4*)(gain + 4 * lane + 256 * j);
    for (int m = gw; m < nrows; m += NGW) {
        const float* xr = X + (size_t)m * DM + 4 * lane;
        f32x4 v[4]; float s = 0.f;
#pragma unroll
        for (int j = 0; j < 4; ++j) { v[j] = *(const f32x4*)(xr + 256 * j); s += (v[j].x * v[j].x + v[j].y * v[j].y) + (v[j].z * v[j].z + v[j].w * v[j].w); }
        const float sc = 1.0f / sqrtf(wave_sum(s, lane) * (1.f / DM) + 1e-6f);
        bf16_t* orow = out + (size_t)m * DM + 4 * lane;
#pragma unroll
        for (int j = 0; j < 4; ++j) { u32x2 w; w.x = pk2(v[j].x * sc * gv[j].x, v[j].y * sc * gv[j].y); w.y = pk2(v[j].z * sc * gv[j].z, v[j].w * sc * gv[j].w); *(u32x2*)(orow + 256 * j) = w; }
        if (Xcopy) {
#pragma unroll
            for (int j = 0; j < 4; ++j) *(f32x4*)(Xcopy + (size_t)m * DM + 4 * lane + 256 * j) = v[j];
        }
    }
}

__device__ __forceinline__ void mem_post_row(const bf16_t* raw, bf16_t* MK, bf16_t* MVT, const float* kgain, int row, int lane) {
    const u32x4 kv = *(const u32x4*)(raw + (size_t)row * 1024 + 8 * lane);
    float v[8] = {bflo(kv.x), bfhi(kv.x), bflo(kv.y), bfhi(kv.y), bflo(kv.z), bfhi(kv.z), bflo(kv.w), bfhi(kv.w)};
    float ss = 0.f;
#pragma unroll
    for (int j = 0; j < 8; ++j) ss += v[j] * v[j];
    ss += shx(ss, 1, lane); ss += shx(ss, 2, lane); ss += shx(ss, 4, lane); ss += shx(ss, 8, lane);
    const float sc = 1.0f / sqrtf(ss * (1.f / 128.f) + 1e-6f);
    const int gc = (8 * lane) & 127;
    u32x4 o; o.x = pk2(v[0] * sc * kgain[gc + 0], v[1] * sc * kgain[gc + 1]); o.y = pk2(v[2] * sc * kgain[gc + 2], v[3] * sc * kgain[gc + 3]);
    o.z = pk2(v[4] * sc * kgain[gc + 4], v[5] * sc * kgain[gc + 5]); o.w = pk2(v[6] * sc * kgain[gc + 6], v[7] * sc * kgain[gc + 7]);
    *(u32x4*)(MK + (size_t)row * 512 + 8 * lane) = o;
    const int b = row >> 8, key = row & 255;
    const u32x4 vv = *(const u32x4*)(raw + (size_t)row * 1024 + 512 + 8 * lane);
    const unsigned wv[4] = {vv.x, vv.y, vv.z, vv.w};
#pragma unroll
    for (int j = 0; j < 8; ++j) { const int col = 8 * lane + j, hm = col >> 7, d = col & 127;
        MVT[((size_t)(b * 4 + hm) * 128 + d) * 256 + key] = (bf16_t)((j & 1) ? (wv[j >> 1] >> 16) : (wv[j >> 1] & 0xffffu)); }
}

constexpr int TT = 8;
struct PrepP {
    const bf16_t* P; const float* VRAp;
    const float *mu, *w0, *decay_b, *a0, *iclr_b, *gate_b, *k_k, *k_a, *v0, *vres_b, *akn;
    bf16_t *R, *K, *V, *G, *KK, *BB, *EW, *VF, *KN, *VT, *LIN, *LBT; const bf16_t *LOA, *LOB;
    int use_vres;
};
__device__ __forceinline__ void lora_bt_build(const PrepP& p, int gtid, int ngt) {
    for (int idx = gtid; idx < 2048 * 48; idx += ngt) {
        const int n = idx & 2047, j = idx >> 11, k0 = 8 * j, q = n >> 9, c = n & 511;
        const float* src = nullptr;
        if (q == 0 && k0 < 64) src = p.decay_b + (size_t)k0 * RW + c;
        else if (q == 1 && k0 >= 64 && k0 < 128) src = p.iclr_b + (size_t)(k0 - 64) * RW + c;
        else if (q == 2 && k0 >= 128 && k0 < 256) src = p.gate_b + (size_t)(k0 - 128) * RW + c;
        else if (q == 3 && k0 >= 256 && k0 < 288 && p.use_vres) src = p.vres_b + (size_t)(k0 - 256) * RW + c;
        u32x4 o = {0u, 0u, 0u, 0u};
        if (src) { o.x = pk2(src[0], src[RW]); o.y = pk2(src[2 * RW], src[3 * RW]); o.z = pk2(src[4 * RW], src[5 * RW]); o.w = pk2(src[6 * RW], src[7 * RW]); }
        *(u32x4*)(p.LBT + (size_t)n * 384 + k0) = o;
    }
}
__device__ __forceinline__ void prepA(const PrepP& p, int bx, int G) {
    int tid_ = threadIdx.x; asm volatile("" : "+v"(tid_));
    const int tid = tid_, lane = tid & 63, wave = tid >> 6;
    for (int idx = bx * 512 + tid; idx < MTOK * 48; idx += G * 512) {
        const int t = idx / 48, j = idx - t * 48;
        u32x4 o = {0u, 0u, 0u, 0u};
        if (j < 32) {
            const int col = 1536 + 8 * j;
            const u32x4 cu = *(const u32x4*)(p.P + (size_t)t * DIN + col);
            u32x4 pv = {0u, 0u, 0u, 0u};
            if ((t % SEQ) != 0) pv = *(const u32x4*)(p.P + (size_t)(t - 1) * DIN + col);
            const f32x4 m0 = *(const f32x4*)(p.mu + col), m1 = *(const f32x4*)(p.mu + col + 4);
            float x[8] = {bflo(cu.x), bfhi(cu.x), bflo(cu.y), bfhi(cu.y), bflo(cu.z), bfhi(cu.z), bflo(cu.w), bfhi(cu.w)};
            const float y[8] = {bflo(pv.x), bfhi(pv.x), bflo(pv.y), bfhi(pv.y), bflo(pv.z), bfhi(pv.z), bflo(pv.w), bfhi(pv.w)};
            const float mm[8] = {m0.x, m0.y, m0.z, m0.w, m1.x, m1.y, m1.z, m1.w};
#pragma unroll
            for (int i = 0; i < 8; ++i) { float v = x[i] + (y[i] - x[i]) * mm[i];
                if (j < 8) { const float e = fexp2(2.f * LOG2E * v); v = 1.f - 2.f * frcp(e + 1.f); }
                else if (j >= 16) v = sigmoidf_(v);
                x[i] = v; }
            o.x = pk2(x[0], x[1]); o.y = pk2(x[2], x[3]); o.z = pk2(x[4], x[5]); o.w = pk2(x[6], x[7]);
        } else if (j < 36 && p.use_vres) {
            const f32x4 a = *(const f32x4*)(p.VRAp + (size_t)t * 32 + 8 * (j - 32)), b = *(const f32x4*)(p.VRAp + (size_t)t * 32 + 8 * (j - 32) + 4);
            o.x = pk2(a.x, a.y); o.y = pk2(a.z, a.w); o.z = pk2(b.x, b.y); o.w = pk2(b.z, b.w);
        }
        *(u32x4*)(p.LIN + (size_t)t * 384 + 8 * j) = o;
    }
    {
        const int h = wave, col = lane & 15, quad = lane >> 4, ch0 = h * 64 + 4 * col;
        const f32x4 akn = *(const f32x4*)(p.akn + 4 * col);
        for (int tile = bx; tile < MTOK / 16; tile += G) {
            const int tq = tile * 16 + 4 * quad, bb_ = tq / SEQ, tpos = tq % SEQ;
            u32x2 vr[4];
#pragma unroll
            for (int i = 0; i < 4; ++i) {
                const bf16_t* q = p.P + (size_t)(tq + i) * DIN;
                const u32x2 kw = *(const u32x2*)(q + COL_AK + ch0);
                const f32x4 ak = {bflo(kw.x), bfhi(kw.x), bflo(kw.y), bfhi(kw.y)};
                const float ss = row16_sum((ak.x * ak.x + ak.y * ak.y) + (ak.z * ak.z + ak.w * ak.w));
                const f32x4 kn = ak * (__builtin_amdgcn_rsqf(ss * (1.f / 64.f) + 1e-6f)) * akn;
                u32x2 w; w.x = pk2(kn.x, kn.y); w.y = pk2(kn.z, kn.w);
                *(u32x2*)(p.KN + (size_t)(tq + i) * RW + ch0) = w;
                vr[i] = *(const u32x2*)(q + COL_AV + ch0);
            }
            bf16_t* vbase = p.VT + ((size_t)(bb_ * 8 + h) * 64 + 4 * col) * SEQ + tpos;
            u32x2 o0, o1, o2, o3;
            o0.x = (vr[0].x & 0xffffu) | (vr[1].x << 16);  o0.y = (vr[2].x & 0xffffu) | (vr[3].x << 16);
            o1.x = (vr[0].x >> 16) | (vr[1].x & 0xffff0000u); o1.y = (vr[2].x >> 16) | (vr[3].x & 0xffff0000u);
            o2.x = (vr[0].y & 0xffffu) | (vr[1].y << 16);  o2.y = (vr[2].y & 0xffffu) | (vr[3].y << 16);
            o3.x = (vr[0].y >> 16) | (vr[1].y & 0xffff0000u); o3.y = (vr[2].y >> 16) | (vr[3].y & 0xffff0000u);
            *(u32x2*)vbase = o0; *(u32x2*)(vbase + SEQ) = o1; *(u32x2*)(vbase + 2 * SEQ) = o2; *(u32x2*)(vbase + 3 * SEQ) = o3;
        }
    }
}
__device__ __forceinline__ f32x4 bf4(u32x2 w) { return (f32x4){bflo(w.x), bfhi(w.x), bflo(w.y), bfhi(w.y)}; }
__device__ __forceinline__ u32x2 pk4(f32x4 v) { u32x2 w; w.x = pk2(v.x, v.y); w.y = pk2(v.z, v.w); return w; }
__device__ __forceinline__ void prepB(const PrepP& p, int bx, int G) {
    int tid_ = threadIdx.x; asm volatile("" : "+v"(tid_));
    const int lane = tid_ & 63, h = tid_ >> 6, col = lane & 15, quad = lane >> 4;
    const int ch0 = h * 64 + 4 * col;
    const f32x4 mu_r = *(const f32x4*)(p.mu + ch0), mu_k = *(const f32x4*)(p.mu + 512 + ch0), mu_v = *(const f32x4*)(p.mu + 1024 + ch0);
    const f32x4 w0c = *(const f32x4*)(p.w0 + ch0), a0c = *(const f32x4*)(p.a0 + ch0), kkc = *(const f32x4*)(p.k_k + ch0), kac = *(const f32x4*)(p.k_a + ch0);
    const f32x4 v0c = p.use_vres ? *(const f32x4*)(p.v0 + ch0) : (f32x4){0.f, 0.f, 0.f, 0.f};
    for (int tile = bx; tile < MTOK / 16; tile += G) {
        const int tq = tile * 16 + 4 * quad;
        f32x4 pr_prev = {0.f, 0.f, 0.f, 0.f}, pk_prev = pr_prev, pv_prev = pr_prev;
        if ((tq % SEQ) != 0) { const bf16_t* q = p.P + (size_t)(tq - 1) * DIN + ch0;
            pr_prev = bf4(*(const u32x2*)q); pk_prev = bf4(*(const u32x2*)(q + 512)); pv_prev = bf4(*(const u32x2*)(q + 1024)); }
#pragma unroll
        for (int i = 0; i < 4; ++i) {
            const size_t t = (size_t)(tq + i);
            const bf16_t* q = p.P + t * DIN + ch0;
            const f32x4 pr = bf4(*(const u32x2*)q), pk = bf4(*(const u32x2*)(q + 512)), pv = bf4(*(const u32x2*)(q + 1024));
            const f32x4 dw = bf4(*(const u32x2*)(p.LOA + t * 1024 + ch0)), da = bf4(*(const u32x2*)(p.LOA + t * 1024 + 512 + ch0));
            const f32x4 dg = bf4(*(const u32x2*)(p.LOB + t * 1024 + ch0)), dv = bf4(*(const u32x2*)(p.LOB + t * 1024 + 512 + ch0));
            const f32x4 r = pr + (pr_prev - pr) * mu_r, k = pk + (pk_prev - pk) * mu_k; f32x4 v = pv + (pv_prev - pv) * mu_v;
            pr_prev = pr; pk_prev = pk; pv_prev = pv;
            f32x4 ew, a;
#pragma unroll
            for (int e = 0; e < 4; ++e) { const float zz = -(w0c[e] + dw[e]);
                const float sp = fmaxf(zz, 0.f) + __logf(1.f + __expf(-fabsf(zz)));
                ew[e] = __expf(-sp - 0.5f); a[e] = sigmoidf_(a0c[e] + da[e]); }
            if (p.use_vres) { const f32x4 vf = bf4(*(const u32x2*)(p.VF + t * RW + ch0));
#pragma unroll
                for (int e = 0; e < 4; ++e) v[e] = v[e] + (vf[e] - v[e]) * sigmoidf_(v0c[e] + dv[e]); }
            else *(u32x2*)(p.VF + t * RW + ch0) = pk4(v);
            f32x4 kk = k * kkc;
            const float ss = row16_sum((kk.x * kk.x + kk.y * kk.y) + (kk.z * kk.z + kk.w * kk.w));
            kk = kk * __builtin_amdgcn_rsqf(fmaxf(ss, 1e-24f));
            const f32x4 k2 = k * (1.f + (a - 1.f) * kac);
            const size_t o = t * RW + ch0;
            *(u32x2*)(p.R + o) = pk4(r); *(u32x2*)(p.K + o) = pk4(k2); *(u32x2*)(p.V + o) = pk4(v); *(u32x2*)(p.G + o) = pk4(dg);
            *(u32x2*)(p.KK + o) = pk4(kk); *(u32x2*)(p.BB + o) = pk4(kk * a); *(u32x2*)(p.EW + o) = pk4(ew);
        }
    }
}


constexpr int SC = 32;
struct ScanP { const bf16_t *R, *K, *V, *KK, *BB, *EW; float* Y; bf16_t* Q; float* SMID; };
constexpr int SEGT = SEQ / 2;
__device__ __forceinline__ void scan_block(LAS unsigned char* lds8, const ScanP& p, int sb) {
    int tid_ = threadIdx.x; asm volatile("" : "+v"(tid_));
    const int tid = tid_, lane = tid & 63, wave = __builtin_amdgcn_readfirstlane(tid >> 6);
    const int bh = sb / 12, jb = sb - bh * 12, b = bh >> 3, h = bh & 7, seg = jb >= 4 ? 1 : 0, oc = seg ? jb - 4 : 0;
    const int base16 = seg ? 16 * (oc >> 1) : 16 * jb;
    const int loc0 = seg ? 8 * (oc & 1) : 0;
    LAS float* lds = (LAS float*)lds8;
    constexpr int STG = 5 * 2048 + 512;
    LAS float* YP = lds + 2 * STG;
    const size_t rowbase = (size_t)b * SEQ + (size_t)seg * SEGT;
    constexpr int NCH = SEGT / SC;
    if (wave >= 4) {
        const int t = tid - 256, ls = t >> 3, c8 = (t & 7) * 8, vi = t & 7;
        const bool hsel = vi >= 4; const int h0 = hsel ? 4 : 0;
        const int colq = h * 64 + c8, colvl = h * 64 + base16 + 2 * vi;
        const int colA = h * 64 + (seg ? 8 * oc : 16 * jb) + vi, colB = h * 64 + (seg ? 8 * oc : 16 * jb + 8) + vi;
        struct LSet { u32x4 ew, r, k, kk, bb; unsigned v; };
        LSet A, B;
#define SCAN_LOAD(S_, ch) do { const size_t ro = (rowbase + (size_t)(ch) * SC + ls) * RW; \
        S_.ew = *(const u32x4*)(p.EW + ro + colq); S_.r = *(const u32x4*)(p.R + ro + colq); S_.k = *(const u32x4*)(p.K + ro + colq); \
        S_.kk = *(const u32x4*)(p.KK + ro + colq); S_.bb = *(const u32x4*)(p.BB + ro + colq); S_.v = *(const unsigned*)(p.V + ro + colvl); } while (0)
#define SCAN_ST8(off, g) do { const f32x4 lo_ = (f32x4){bflo(g.x), bfhi(g.x), bflo(g.y), bfhi(g.y)}, hi_ = (f32x4){bflo(g.z), bfhi(g.z), bflo(g.w), bfhi(g.w)}; \
        *(LAS f32x4*)(sg + (off) + o + h0) = hsel ? hi_ : lo_; *(LAS f32x4*)(sg + (off) + o + 4 - h0) = hsel ? lo_ : hi_; } while (0)
#define SCAN_STORE(S_, st) do { LAS float* sg = lds + (st) * STG; const int o = ls * 64 + c8; \
        { const f32x4 lo_ = (f32x4){__expf(-bflo(S_.ew.x)), __expf(-bfhi(S_.ew.x)), __expf(-bflo(S_.ew.y)), __expf(-bfhi(S_.ew.y))}; \
          const f32x4 hi_ = (f32x4){__expf(-bflo(S_.ew.z)), __expf(-bfhi(S_.ew.z)), __expf(-bflo(S_.ew.w)), __expf(-bfhi(S_.ew.w))}; \
          *(LAS f32x4*)(sg + o + h0) = hsel ? hi_ : lo_; *(LAS f32x4*)(sg + o + 4 - h0) = hsel ? lo_ : hi_; } \
        SCAN_ST8(2048, S_.k); SCAN_ST8(4096, S_.kk); SCAN_ST8(6144, S_.bb); SCAN_ST8(8192, S_.r); \
        *(LAS f32x2*)(sg + 10240 + ls * 16 + 2 * vi) = (f32x2){bflo(S_.v), bfhi(S_.v)}; } while (0)
#define SCAN_YRED(stq, chq) do { float ya, yb; \
        { const LAS f32x4* yp = (const LAS f32x4*)(YP + (stq) * 8192 + (ls * 16 + vi) * 16); \
          const f32x4 a0 = yp[ls & 3], a1 = yp[(ls + 1) & 3], a2 = yp[(ls + 2) & 3], a3 = yp[(ls + 3) & 3]; const f32x4 sa_ = (a0 + a1) + (a2 + a3); ya = (sa_.x + sa_.y) + (sa_.z + sa_.w); } \
        { const LAS f32x4* yp = (const LAS f32x4*)(YP + (stq) * 8192 + (ls * 16 + 8 + vi) * 16); \
          const f32x4 a0 = yp[ls & 3], a1 = yp[(ls + 1) & 3], a2 = yp[(ls + 2) & 3], a3 = yp[(ls + 3) & 3]; const f32x4 sa_ = (a0 + a1) + (a2 + a3); yb = (sa_.x + sa_.y) + (sa_.z + sa_.w); } \
        const size_t tok_ = rowbase + (size_t)(chq) * SC + ls; \
        p.Y[tok_ * RW + colA] = ya; \
        if (seg) p.Q[((size_t)b * SEGT + (size_t)(chq) * SC + ls) * RW + colB] = (bf16_t)f2bf(yb); else p.Y[tok_ * RW + colB] = yb; } while (0)
        SCAN_LOAD(A, 0); SCAN_STORE(A, 0); SCAN_LOAD(A, 1); SCAN_LOAD(B, 2);
        __syncthreads();
        for (int ch = 0; ch < NCH; ch += 2) {
            SCAN_STORE(A, 1);
            if (ch + 3 < NCH) SCAN_LOAD(A, ch + 3);
            if (ch >= 1) { SCAN_YRED(1, ch - 1); }
            __syncthreads();
            if (ch + 2 < NCH) SCAN_STORE(B, 0);
            if (ch + 4 < NCH) SCAN_LOAD(B, ch + 4);
            SCAN_YRED(0, ch);
            __syncthreads();
        }
        { SCAN_YRED(1, NCH - 1); }
#undef SCAN_LOAD
#undef SCAN_ST8
#undef SCAN_STORE
#undef SCAN_YRED
    } else {
        const int rg = lane >> 4, kq = lane & 15, lrow = 4 * wave + rg;
        const bool probe = seg && lrow >= 8;
        const int vrow = seg ? loc0 + (lrow & 7) : lrow, pidx = 8 * oc + (lrow & 7);
        const float vm = probe ? 0.f : 1.f;
        f32x2 S01 = {0.f, 0.f}, S23 = {0.f, 0.f};
        if (probe) { S01.x = (4 * kq + 0 == pidx) ? 1.f : 0.f; S01.y = (4 * kq + 1 == pidx) ? 1.f : 0.f; S23.x = (4 * kq + 2 == pidx) ? 1.f : 0.f; S23.y = (4 * kq + 3 == pidx) ? 1.f : 0.f; }
        __syncthreads();
        for (int ch = 0; ch < NCH; ++ch) {
            const int st = ch & 1;
            const LAS float* sg = lds + st * STG;
            LAS float* ydst = YP + st * 8192 + lrow * 16 + kq;
            f32x4 w = *(const LAS f32x4*)(sg + 4 * kq), kv = *(const LAS f32x4*)(sg + 2048 + 4 * kq), kk = *(const LAS f32x4*)(sg + 4096 + 4 * kq);
            f32x4 bb = *(const LAS f32x4*)(sg + 6144 + 4 * kq), r = *(const LAS f32x4*)(sg + 8192 + 4 * kq);
            float v = sg[10240 + vrow] * vm;
#pragma unroll 8
            for (int s = 0; s < SC; ++s) {
                const int sn = (s + 1 < SC) ? s + 1 : s;
                const int o = sn * 64 + 4 * kq;
                const f32x4 nw = *(const LAS f32x4*)(sg + o), nkv = *(const LAS f32x4*)(sg + 2048 + o), nkk = *(const LAS f32x4*)(sg + 4096 + o);
                const f32x4 nbb = *(const LAS f32x4*)(sg + 6144 + o), nr = *(const LAS f32x4*)(sg + 8192 + o);
                const float nv = sg[10240 + sn * 16 + vrow] * vm;
                const f32x2 vv = {v, v};
                const f32x2 d2 = S01 * (f32x2){kk.x, kk.y} + S23 * (f32x2){kk.z, kk.w};
                const float sa = row16_sum(d2.x + d2.y);
                const f32x2 nsa = {-sa, -sa};
                S01 = (S01 * (f32x2){w.x, w.y} + vv * (f32x2){kv.x, kv.y}) + nsa * (f32x2){bb.x, bb.y};
                S23 = (S23 * (f32x2){w.z, w.w} + vv * (f32x2){kv.z, kv.w}) + nsa * (f32x2){bb.z, bb.w};
                const f32x2 y2 = S01 * (f32x2){r.x, r.y} + S23 * (f32x2){r.z, r.w};
                ydst[s * 256] = y2.x + y2.y;
                w = nw; kv = nkv; kk = nkk; bb = nbb; r = nr; v = nv;
            }
            __syncthreads();
        }
        if (seg == 0) *(f32x4*)(p.SMID + ((size_t)bh * 64 + 16 * jb + lrow) * 64 + 4 * kq) = (f32x4){S01.x, S01.y, S23.x, S23.y};
    }
    __syncthreads();
}

struct PostP { const float* Y; const bf16_t *R, *K, *V, *G; const float *r_k, *gn_g, *gn_b; bf16_t* O; const bf16_t* Q; const float* SMID; };
__device__ __forceinline__ void rwkv_post(const PostP& p, int blk, int nblk) {
    int tid_ = threadIdx.x; asm volatile("" : "+v"(tid_));
    const int lane = tid_ & 63, h = tid_ >> 6, col = lane & 15, quad = lane >> 4;
    const int ch0 = h * 64 + 4 * col;
    const f32x4 rk = *(const f32x4*)(p.r_k + ch0), gg = *(const f32x4*)(p.gn_g + ch0), gb = *(const f32x4*)(p.gn_b + ch0);
    bf16x8 Bf[4][2]; int bcur = -1;
    for (int tile = blk; tile < MTOK / 16; tile += nblk) {
        const int t0 = tile * 16, bq = t0 / SEQ, tpos = t0 % SEQ;
        f32x4 corr[4];
#pragma unroll
        for (int n = 0; n < 4; ++n) corr[n] = (f32x4){0.f, 0.f, 0.f, 0.f};
        if (tpos >= SEGT) {
            if (bq != bcur) { bcur = bq;
#pragma unroll
                for (int n = 0; n < 4; ++n) { const float* sr = p.SMID + ((size_t)(bq * 8 + h) * 64 + 4 * col + n) * 64 + 8 * quad;
#pragma unroll
                    for (int ks = 0; ks < 2; ++ks) { const f32x4 a = *(const f32x4*)(sr + 32 * ks), c4 = *(const f32x4*)(sr + 32 * ks + 4);
                        u32x4 w; w.x = pk2(a.x, a.y); w.y = pk2(a.z, a.w); w.z = pk2(c4.x, c4.y); w.w = pk2(c4.z, c4.w); Bf[n][ks] = __builtin_bit_cast(bf16x8, w); } } }
            const bf16_t* qrow = p.Q + ((size_t)bq * SEGT + (size_t)(tpos - SEGT) + col) * RW + h * 64 + 8 * quad;
            const bf16x8 A0 = *(const bf16x8*)qrow, A1 = *(const bf16x8*)(qrow + 32);
#pragma unroll
            for (int n = 0; n < 4; ++n) { const f32x4 a = __builtin_amdgcn_mfma_f32_16x16x32_bf16(A0, Bf[n][0], (f32x4){0.f, 0.f, 0.f, 0.f}, 0, 0, 0);
                corr[n] = __builtin_amdgcn_mfma_f32_16x16x32_bf16(A1, Bf[n][1], a, 0, 0, 0); }
        }
#pragma unroll
        for (int i = 0; i < 4; ++i) {
            const size_t o = (size_t)(t0 + 4 * quad + i) * RW + ch0;
            f32x4 y = *(const f32x4*)(p.Y + o);
            y.x += corr[0][i]; y.y += corr[1][i]; y.z += corr[2][i]; y.w += corr[3][i];
            const u32x2 rr = *(const u32x2*)(p.R + o), kk = *(const u32x2*)(p.K + o), vv = *(const u32x2*)(p.V + o), gq = *(const u32x2*)(p.G + o);
            const f32x4 r = {bflo(rr.x), bfhi(rr.x), bflo(rr.y), bfhi(rr.y)}, k = {bflo(kk.x), bfhi(kk.x), bflo(kk.y), bfhi(kk.y)};
            const f32x4 v = {bflo(vv.x), bfhi(vv.x), bflo(vv.y), bfhi(vv.y)}, g = {bflo(gq.x), bfhi(gq.x), bflo(gq.y), bfhi(gq.y)};
            const float mean = row16_sum((y.x + y.y) + (y.z + y.w)) * (1.f / 64.f);
            const f32x4 d = y - mean;
            const float var = row16_sum((d.x * d.x + d.y * d.y) + (d.z * d.z + d.w * d.w)) * (1.f / 64.f);
            const float rstd = __builtin_amdgcn_rsqf(var + 64e-5f);
            const f32x4 rkk = r * k * rk;
            const float bon = row16_sum((rkk.x + rkk.y) + (rkk.z + rkk.w));
            const f32x4 out = ((d * rstd) * gg + gb + v * bon) * g;
            u32x2 w; w.x = pk2(out.x, out.y); w.y = pk2(out.z, out.w);
            *(u32x2*)(p.O + o) = w;
        }
    }
}

template <int DH, bool BIAS>
__device__ __forceinline__ void attn_wave(const bf16_t* Qp, int ldq, const float* qgain, float qscale,
                                          const bf16_t* Kp, int ldk, const bf16_t* Vt, int ldv,
                                          int nchunks, int j0, int qoff, const LAS float* bias,
                                          bf16_t* Op, int ldo, int lane) {
    constexpr int NKS = DH / 32, NDT = DH / 16;
    const int fr = lane & 15, fq = lane >> 4;
    bf16x8 Qf[2][NKS];
#pragma unroll
    for (int qg = 0; qg < 2; ++qg) {
        float vals[NKS][8]; float ss = 0.f;
#pragma unroll
        for (int ks = 0; ks < NKS; ++ks) { const u32x4 raw = *(const u32x4*)(Qp + (size_t)(16 * qg + fr) * ldq + 32 * ks + 8 * fq);
            vals[ks][0] = bflo(raw.x); vals[ks][1] = bfhi(raw.x); vals[ks][2] = bflo(raw.y); vals[ks][3] = bfhi(raw.y);
            vals[ks][4] = bflo(raw.z); vals[ks][5] = bfhi(raw.z); vals[ks][6] = bflo(raw.w); vals[ks][7] = bfhi(raw.w);
#pragma unroll
            for (int j = 0; j < 8; ++j) ss += vals[ks][j] * vals[ks][j]; }
        ss += shx(ss, 16, lane); ss += shx(ss, 32, lane);
        const float sc = (1.0f / sqrtf(ss * (1.f / DH) + 1e-6f)) * qscale;
#pragma unroll
        for (int ks = 0; ks < NKS; ++ks) { const f32x4 g0 = *(const f32x4*)(qgain + 32 * ks + 8 * fq), g1 = *(const f32x4*)(qgain + 32 * ks + 8 * fq + 4);
            u32x4 w; w.x = pk2(vals[ks][0] * sc * g0.x, vals[ks][1] * sc * g0.y); w.y = pk2(vals[ks][2] * sc * g0.z, vals[ks][3] * sc * g0.w);
            w.z = pk2(vals[ks][4] * sc * g1.x, vals[ks][5] * sc * g1.y); w.w = pk2(vals[ks][6] * sc * g1.z, vals[ks][7] * sc * g1.w);
            Qf[qg][ks] = __builtin_bit_cast(bf16x8, w); }
    }
    f32x4 O[NDT][2];
#pragma unroll
    for (int dt = 0; dt < NDT; ++dt) { O[dt][0] = (f32x4){0.f, 0.f, 0.f, 0.f}; O[dt][1] = (f32x4){0.f, 0.f, 0.f, 0.f}; }
    float mrun[2] = {-1e30f, -1e30f}, lsum[2] = {0.f, 0.f};
    for (int ci = 0; ci < nchunks; ++ci) {
        const bf16_t* Kc = Kp + (size_t)ci * 64 * ldk; const bf16_t* Vc = Vt + ci * 64;
        f32x4 S[4][2];
#pragma unroll
        for (int kt = 0; kt < 4; ++kt) {
            bf16x8 Kf[NKS];
#pragma unroll
            for (int ks = 0; ks < NKS; ++ks) Kf[ks] = *(const bf16x8*)(Kc + (size_t)(32 * (kt >> 1) + 8 * (fr >> 2) + 4 * (kt & 1) + (fr & 3)) * ldk + 32 * ks + 8 * fq);
#pragma unroll
            for (int qg = 0; qg < 2; ++qg) { f32x4 a = (f32x4){0.f, 0.f, 0.f, 0.f};
#pragma unroll
                for (int ks = 0; ks < NKS; ++ks) a = __builtin_amdgcn_mfma_f32_16x16x32_bf16(Kf[ks], Qf[qg][ks], a, 0, 0, 0);
                S[kt][qg] = a; }
        }
        if (BIAS) {
            const int j = j0 + ci;
            if (j <= 5) { const float bc = bias[NREL - 1];
#pragma unroll
                for (int kt = 0; kt < 4; ++kt)
#pragma unroll
                    for (int qg = 0; qg < 2; ++qg) S[kt][qg] = S[kt][qg] + bc;
            } else {
                const int dbase = (8 - j) * 64 + qoff + fr - 8 * fq + 63;
#pragma unroll
                for (int kt = 0; kt < 4; ++kt)
#pragma unroll
                    for (int qg = 0; qg < 2; ++qg)
#pragma unroll
                        for (int i = 0; i < 4; ++i) { int idx = dbase + 16 * qg - 32 * (kt >> 1) - 4 * (kt & 1) - i; idx = idx < 0 ? 0 : (idx > NREL - 1 ? NREL - 1 : idx); S[kt][qg][i] += bias[idx]; }
            }
        }
        bf16x8 Pf[2][2];
#pragma unroll
        for (int qg = 0; qg < 2; ++qg) {
            float mx = -1e30f;
#pragma unroll
            for (int kt = 0; kt < 4; ++kt)
#pragma unroll
                for (int i = 0; i < 4; ++i) mx = fmaxf(mx, S[kt][qg][i]);
            mx = fmaxf(mx, shx(mx, 16, lane)); mx = fmaxf(mx, shx(mx, 32, lane));
            const float mn = fmaxf(mrun[qg], mx), alpha = fexp2(mrun[qg] - mn); mrun[qg] = mn;
            float ps = 0.f;
#pragma unroll
            for (int kt = 0; kt < 4; ++kt)
#pragma unroll
                for (int i = 0; i < 4; ++i) { const float pv = fexp2(S[kt][qg][i] - mn); S[kt][qg][i] = pv; ps += pv; }
            lsum[qg] = lsum[qg] * alpha + ps;
#pragma unroll
            for (int dt = 0; dt < NDT; ++dt) O[dt][qg] = O[dt][qg] * alpha;
#pragma unroll
            for (int s = 0; s < 2; ++s) { u32x4 w; w.x = pk2(S[2 * s][qg][0], S[2 * s][qg][1]); w.y = pk2(S[2 * s][qg][2], S[2 * s][qg][3]);
                w.z = pk2(S[2 * s + 1][qg][0], S[2 * s + 1][qg][1]); w.w = pk2(S[2 * s + 1][qg][2], S[2 * s + 1][qg][3]); Pf[qg][s] = __builtin_bit_cast(bf16x8, w); }
        }
#pragma unroll
        for (int dt = 0; dt < NDT; ++dt)
#pragma unroll
            for (int s = 0; s < 2; ++s) { const bf16x8 Vf = *(const bf16x8*)(Vc + (size_t)(16 * dt + fr) * ldv + 32 * s + 8 * fq);
#pragma unroll
                for (int qg = 0; qg < 2; ++qg) O[dt][qg] = __builtin_amdgcn_mfma_f32_16x16x32_bf16(Vf, Pf[qg][s], O[dt][qg], 0, 0, 0); }
    }
#pragma unroll
    for (int qg = 0; qg < 2; ++qg) {
        float l = lsum[qg]; l += shx(l, 16, lane); l += shx(l, 32, lane);
        const float inv = 1.0f / l;
#pragma unroll
        for (int dt = 0; dt < NDT; ++dt) { const f32x4 o = O[dt][qg] * inv; u32x2 w; w.x = pk2(o[0], o[1]); w.y = pk2(o[2], o[3]);
            *(u32x2*)(Op + (size_t)(16 * qg + fr) * ldo + 16 * dt + 4 * fq) = w; }
    }
}

struct AttnP { const bf16_t *P, *KN, *VT, *MK, *MVT; const float *aqn, *mqn, *rel; bf16_t *Yatt, *Ymem; };
__device__ __forceinline__ void attn_unit(LAS float* wlds, const AttnP& p, int u, int lane_) {
    int lane = lane_; asm volatile("" : "+v"(lane));
    if (u < 4096) {
        const int qh = u & 1, h = (u >> 1) & 7, c = (u >> 4) & 127, b = u >> 11;
#pragma unroll
        for (int i = 0; i < 3; ++i) wlds[lane + 64 * i] = p.rel[h * NREL + lane + 64 * i] * LOG2E;
        LDS_WAIT(); asm volatile("" ::: "memory");
        const int js = (8 - c) > 0 ? (8 - c) : 0, kc0 = c - 8 + js;
        const size_t q0 = (size_t)b * SEQ + c * 64 + 32 * qh;
        attn_wave<64, true>(p.P + q0 * DIN + COL_AQ + h * 64, DIN, p.aqn, 0.125f * LOG2E,
                            p.KN + ((size_t)b * SEQ + kc0 * 64) * RW + h * 64, RW,
                            p.VT + ((size_t)(b * 8 + h) * 64) * SEQ + kc0 * 64, SEQ,
                            9 - js, js, 32 * qh, wlds, p.Yatt + q0 * RW + h * 64, RW, lane);
        LDS_WAIT(); asm volatile("" ::: "memory");
    } else {
        const int mu = u - 4096, hm = mu & 3, tile = mu >> 2, b = tile >> 8;
        const size_t q0 = (size_t)tile * 32;
        attn_wave<128, false>(p.P + q0 * DIN + COL_MQ + hm * 128, DIN, p.mqn, 0.08838834764831845f * LOG2E,
                              p.MK + ((size_t)b * 256) * 512 + hm * 128, 512,
                              p.MVT + ((size_t)(b * 4 + hm) * 128) * 256, 256,
                              4, 0, 0, wlds, p.Ymem + q0 * RW + hm * 128, RW, lane);
    }
}


#define XB_TMO      128
#define XB_XCNT(j)  (256  + 64 * (j))
#define XB_XSUB(j)  (1280 + 64 * (j))
#define XB_XGEN(j)  (2304 + 64 * (j))
#define XB_TOP      3328
#define XB_TOPGEN   3392
#define XCD_BAR_WORDS 3456
#define XB_SPIN_CAP (1u << 18)
__device__ __forceinline__ unsigned xb_ld(unsigned* p)              { return __hip_atomic_load(p, __ATOMIC_RELAXED, __HIP_MEMORY_SCOPE_AGENT); }
__device__ __forceinline__ unsigned xb_add(unsigned* p, unsigned v) { return __hip_atomic_fetch_add(p, v, __ATOMIC_RELAXED, __HIP_MEMORY_SCOPE_AGENT); }
__device__ __forceinline__ unsigned xb_xcc_id() { return (unsigned)__builtin_amdgcn_s_getreg((3 << 11) | 20) & 0xFu; }
#define XB_SPIN(cond, bar) do { unsigned _sp = 0; while (cond) { __builtin_amdgcn_s_sleep(1); \
    if ((++_sp & 255u) == 0u) { if (xb_ld(&(bar)[XB_TMO])) break; if (_sp > XB_SPIN_CAP) { atomicAdd(&(bar)[XB_TMO], 1u); break; } } } } while (0)
struct XcdBarrier { unsigned* bar; unsigned x; volatile LAS unsigned* st; };
__device__ __forceinline__ XcdBarrier xcd_barrier_post(unsigned* bar, volatile LAS unsigned* st) {
    XcdBarrier b; b.bar = bar; b.x = xb_xcc_id(); b.st = st;
    if (threadIdx.x == 0) (void)xb_add(&bar[XB_XCNT(b.x)], 1u);
    return b;
}
__device__ __forceinline__ void xcd_barrier_complete(unsigned* bar, unsigned x, unsigned& nloc, unsigned& nx) {
    const unsigned G = gridDim.x * gridDim.y * gridDim.z;
    unsigned sum, cnt, mine, sp = 0u;
    for (;;) {
        sum = 0u; cnt = 0u; mine = 0u;
#pragma unroll
        for (unsigned j = 0; j < 16; ++j) { const unsigned c = xb_ld(&bar[XB_XCNT(j)]); sum += c; cnt += (c > 0u) ? 1u : 0u; mine = (j == x) ? c : mine; }
        if (sum == G) break;
        __builtin_amdgcn_s_sleep(1);
        if ((++sp & 255u) == 0u) { if (xb_ld(&bar[XB_TMO])) break; if (sp > XB_SPIN_CAP) { atomicAdd(&bar[XB_TMO], 1u); break; } }
    }
    nloc = mine > 0u ? mine : 1u; nx = cnt > 0u ? cnt : 1u;
}
__device__ __forceinline__ void xcd_barrier(unsigned* bar, volatile LAS unsigned* st) {
    asm volatile("s_waitcnt vmcnt(0)" ::: "memory");
    __syncthreads();
    if (threadIdx.x == 0) {
        const unsigned x = xb_xcc_id();
        __builtin_amdgcn_s_waitcnt(0);
        unsigned nloc = st[0], nx = st[1];
        if (nloc == 0u) { xcd_barrier_complete(bar, x, nloc, nx); st[0] = nloc; st[1] = nx; }
        const unsigned old = xb_add(&bar[XB_XSUB(x)], 1u);
        const unsigned gen = old / nloc;
        if (old + 1u == (gen + 1u) * nloc) {
            __builtin_amdgcn_fence(__ATOMIC_RELEASE, "agent");
            asm volatile("s_waitcnt vmcnt(0)" ::: "memory");
            const unsigned og = xb_add(&bar[XB_TOP], 1u);
            const unsigned tg = og / nx;
            if (og + 1u == (tg + 1u) * nx) xb_add(&bar[XB_TOPGEN], 1u);
            else XB_SPIN(xb_ld(&bar[XB_TOPGEN]) == tg, bar);
            __builtin_amdgcn_fence(__ATOMIC_ACQUIRE, "agent");
            xb_add(&bar[XB_XGEN(x)], 1u);
            asm volatile("s_waitcnt vmcnt(0)" ::: "memory");
        } else {
            XB_SPIN(xb_ld(&bar[XB_XGEN(x)]) == gen, bar);
            __builtin_amdgcn_fence(__ATOMIC_ACQUIRE, "agent");
            asm volatile("s_waitcnt vmcnt(0)" ::: "memory");
        }
    }
    __syncthreads();
}


__device__ __forceinline__ void dbg_dump(float* X, const unsigned char* wsb, size_t off_f32, size_t off_a, size_t off_b, int G, int bx) {
    const size_t n = (size_t)MTOK * 512;
    int t_ = threadIdx.x; asm volatile("" : "+v"(t_));
    for (size_t i = (size_t)bx * 512 + t_; i < n / 2; i += (size_t)G * 512) {
        const unsigned wa = off_a ? __hip_atomic_load((unsigned*)(wsb + off_a) + i, __ATOMIC_RELAXED, __HIP_MEMORY_SCOPE_AGENT) : 0u;
        const unsigned wb = off_b ? __hip_atomic_load((unsigned*)(wsb + off_b) + i, __ATOMIC_RELAXED, __HIP_MEMORY_SCOPE_AGENT) : 0u;
        X[2 * i] = bflo(wa) + bflo(wb); X[2 * i + 1] = bfhi(wa) + bfhi(wb);
        X[n + 2 * i] = 0.f; X[n + 2 * i + 1] = 0.f;
    }
}
__device__ __forceinline__ const float* tabp(const LAS unsigned long long* tab, int i) {
    unsigned b = (unsigned)(size_t)tab; asm volatile("" : "+v"(b));
    const unsigned long long v = ((const LAS unsigned long long*)(size_t)b)[i];
    const unsigned lo = __builtin_amdgcn_readfirstlane((unsigned)v), hi = __builtin_amdgcn_readfirstlane((unsigned)(v >> 32));
    const __attribute__((address_space(1))) float* g = (const __attribute__((address_space(1))) float*)(((unsigned long long)hi << 32) | lo);
    return (const float*)g;
}
#define IN(i) tabp(ptab, (i))
#define FRESH_LANE() ({ int _t = threadIdx.x; asm volatile("" : "+v"(_t)); _t & 63; })
#define WSP ((unsigned char*)tabp(ptab, 38))
#define WSP_EARLY ((unsigned char*)tabp(ptab, 38))
#define XOUT ((float*)tabp(ptab, 37))
__global__ void __launch_bounds__(512, 2) mega_fwd(Args a_unused) {
    extern __shared__ __attribute__((aligned(16))) unsigned char lds_raw[];
    cg::grid_group grid = cg::this_grid();
    LAS unsigned char* lds = (LAS unsigned char*)lds_raw;
    const int tid = threadIdx.x, wave = __builtin_amdgcn_readfirstlane(tid >> 6);
    LAS unsigned long long* ptab = (LAS unsigned long long*)(lds + PTAB_OFF);
    { const unsigned long long* ka = (const unsigned long long*)__builtin_amdgcn_kernarg_segment_ptr(); if (tid < 39) ptab[tid] = ka[tid]; }
    volatile LAS unsigned* bst = (volatile LAS unsigned*)(lds + PTAB_OFF + 512);
    if (tid < 2) bst[tid] = 0u;
    __syncthreads();
    grid.sync();
    (void)xcd_barrier_post((unsigned*)WSP_EARLY, bst);
#define GSYNC() xcd_barrier((unsigned*)WSP, bst)
    const int G0 = gridDim.x, bx0 = blockIdx.x;
    LAS float* wscr = (LAS float*)(lds + wave * 16384);
#define W1A ((bf16_t*)(WSP + WS_W1A))
#define W1B ((bf16_t*)(WSP + WS_W1B))
#define WP ((bf16_t*)(WSP + WS_WP))
#define WBR ((bf16_t*)(WSP + WS_WBR))
#define WO ((bf16_t*)(WSP + WS_WO))
#define HN ((bf16_t*)(WSP + WS_HN))
#define PROJ ((bf16_t*)(WSP + WS_PROJ))
#define ACT PROJ
#define GATES ((bf16_t*)(WSP + WS_GATES))
#define VRA ((float*)(WSP + WS_VRA))
#define X XOUT
#define ws WSP

    {
        const int gw = bx0 * 8 + wave, NGW = G0 * 8, lane = FRESH_LANE();
        int base = 0;
        for (int l = 0; l < 4; ++l) tr_job(IN(25) + (size_t)l * DM * DM, (bf16_t*)(ws + WS_WMKV) + (size_t)l * DM * DM, DM, DM, 0, 0, base, wscr, gw, NGW, lane);
        for (int l = 0; l < 4; ++l) rms_rows(IN(1), nullptr, IN(24) + l * DM, (bf16_t*)(ws + WS_MEMN) + (size_t)l * 512 * DM, 512, gw, NGW, lane);
    }
    for (int l_ = 0; l_ < DEPTH; ++l_) {
        int l = l_, G = G0, bx = bx0; asm volatile("" : "+s"(l), "+s"(G), "+s"(bx));
        const int gw = bx * 8 + wave, NGW = G * 8;
        {
            const int lane = FRESH_LANE();
            int base = 0;
            tr_job(IN(3) + (size_t)l * DM * 2 * DFF, W1A, DM, 2 * DFF, 1, 0, base, wscr, gw, NGW, lane);
            tr_job(IN(4) + (size_t)l * DFF * DM, W1B, DFF, DM, 0, 0, base, wscr, gw, NGW, lane);
            tr_job(IN(6) + (size_t)l * DM * DIN, WP, DM, DIN, 0, 0, base, wscr, gw, NGW, lane);
            tr_job(IN(31) + (size_t)l * DM * 3072, WP, DM, 3072, 0, DIN, base, wscr, gw, NGW, lane);
            tr_job(IN(29) + (size_t)l * RW * DM, WBR, RW, DM, 0, 0, base, wscr, gw, NGW, lane);
            tr_job(IN(30) + (size_t)l * RW * DM, WBR, RW, DM, 0, 1024, base, wscr, gw, NGW, lane);
            tr_job(IN(28) + (size_t)l * RW * DM, WBR, RW, DM, 0, 2048, base, wscr, gw, NGW, lane);
            tr_job(IN(33) + (size_t)l * DM * DM, WO, DM, DM, 0, 0, base, wscr, gw, NGW, lane);
            if (l > 0) tr_job(IN(19) + (size_t)(l - 1) * DM * 32, WP, DM, 32, 0, DIN + 3072, base, wscr, gw, NGW, lane);
            if (l == 0) rms_rows(IN(0), X, IN(2), HN, MTOK, gw, NGW, lane);
            else rms_rows(X, nullptr, IN(2) + l * DM, HN, MTOK, gw, NGW, lane);
        }
        GSYNC();
        if (STOP_AT == 1 && l == STOP_LAYER) return;
        if (l == 0) {
            pg8::Gemm g{(const bf16_t*)(ws + WS_MEMN), (const bf16_t*)(ws + WS_WMKV), (size_t)512 * DM * 2, (size_t)DM * DM * 2, 512, DM, DM};
            pg8::ZOrder S{G, bx};
            pg8::EpiPlain E{(bf16_t*)(ws + WS_MKVRAW), DM, (size_t)512 * DM};
            pg8::gemm_phase<pg8::EpiPlain, pg8::ZOrder>(lds, g, S, E);
            GSYNC();
        if (STOP_AT == 2 && l == STOP_LAYER) return;
            const int lane = FRESH_LANE();
            for (int r = gw; r < 4 * 512; r += NGW) { const int ll = r >> 9, row = r & 511;
                mem_post_row((const bf16_t*)(ws + WS_MKVRAW) + (size_t)ll * 512 * DM, (bf16_t*)(ws + WS_MK) + (size_t)ll * 512 * 512, (bf16_t*)(ws + WS_MVT) + (size_t)ll * 8 * 128 * 256, IN(27) + ll * 128, row, lane); }
        }
        { pg8::Gemm g{HN, W1A, 0, 0, MTOK, 2 * DFF, DM}; pg8::StaticOrder S; S.init(MTOK, 2 * DFF, G, bx); pg8::EpiSwiglu E{ACT};
          pg8::gemm_phase<pg8::EpiSwiglu, pg8::StaticOrder>(lds, g, S, E); }
        GSYNC();
        if (STOP_AT == 3 && l == STOP_LAYER) return;
        { pg8::Gemm g{ACT, W1B, 0, 0, MTOK, DM, DFF}; pg8::StaticOrder S; S.init(MTOK, DM, G, bx); pg8::EpiResid E{X, 0.5f};
          pg8::gemm_phase<pg8::EpiResid, pg8::StaticOrder>(lds, g, S, E); }
        GSYNC();
        if (STOP_AT == 4 && l == STOP_LAYER) return;
        {
            const int lane = FRESH_LANE();
            rms_rows(X, nullptr, IN(5) + l * DM, HN, MTOK, gw, NGW, lane);
            int base = 0;
            tr_job(IN(35) + (size_t)l * DM * 2 * DFF, W1A, DM, 2 * DFF, 1, 0, base, wscr, gw, NGW, lane);
            tr_job(IN(36) + (size_t)l * DFF * DM, W1B, DFF, DM, 0, 0, base, wscr, gw, NGW, lane);
        }
        GSYNC();
        if (STOP_AT == 5 && l == STOP_LAYER) return;
        { const int N = (l > 0) ? 7168 : 6912;
          pg8::Gemm g{HN, WP, 0, 0, MTOK, N, DM}; pg8::StaticOrder S; S.init(MTOK, N, G, bx); pg8::EpiProj E{PROJ, GATES, VRA, IN(32) + l * 3072};
          pg8::gemm_phase<pg8::EpiProj, pg8::StaticOrder>(lds, g, S, E); }
        GSYNC();
        if (STOP_AT == 6 && l == STOP_LAYER) { dbg_dump(X, ws, 0, DBG_A, DBG_B, G, bx); return; }
        {
#define PREP_SETUP() \
            const int li = l > 0 ? l - 1 : 0; \
            PrepP p; \
            p.P = PROJ; p.VRAp = VRA; p.mu = IN(7) + l * RWKV_IN; p.w0 = IN(8) + l * RW; p.decay_b = IN(9) + (size_t)l * 64 * RW; p.a0 = IN(10) + l * RW; \
            p.iclr_b = IN(11) + (size_t)l * 64 * RW; p.gate_b = IN(12) + (size_t)l * 128 * RW; p.k_k = IN(13) + l * RW; p.k_a = IN(14) + l * RW; \
            p.v0 = IN(18) + li * RW; p.vres_b = IN(20) + (size_t)li * 32 * RW; p.akn = IN(22) + l * 64; \
            p.R = (bf16_t*)(ws + WS_R); p.K = (bf16_t*)(ws + WS_K); p.V = (bf16_t*)(ws + WS_V); p.G = (bf16_t*)(ws + WS_G); p.KK = (bf16_t*)(ws + WS_KK); \
            p.BB = (bf16_t*)(ws + WS_BB); p.EW = (bf16_t*)(ws + WS_EW); p.VF = (bf16_t*)(ws + WS_VFIRST); p.KN = (bf16_t*)(ws + WS_KN); p.VT = (bf16_t*)(ws + WS_VT); \
            p.LIN = (bf16_t*)(ws + WS_LIN); p.LBT = (bf16_t*)(ws + WS_LBT); p.LOA = (const bf16_t*)(ws + WS_LOA); p.LOB = (const bf16_t*)(ws + WS_LOB); \
            p.use_vres = l > 0; \

            { PREP_SETUP()
            { int t_ = threadIdx.x; asm volatile("" : "+v"(t_)); lora_bt_build(p, bx * 512 + t_, G * 512); }
            prepA(p, bx, G); }
            GSYNC();
            { pg8::Gemm g{(const bf16_t*)(ws + WS_LIN), (const bf16_t*)(ws + WS_LBT), 0, 0, MTOK, 2048, 384}; pg8::StaticOrder S; S.init(MTOK, 2048, G, bx);
              pg8::EpiSplit2 E{(bf16_t*)(ws + WS_LOA), (bf16_t*)(ws + WS_LOB)};
              pg8::gemm_phase<pg8::EpiSplit2, pg8::StaticOrder>(lds, g, S, E); }
            GSYNC();
            { PREP_SETUP()
            prepB(p, bx, G); }
        }
        GSYNC();
        if (STOP_AT == 7 && l == STOP_LAYER) return;
        {
            AttnP ap{PROJ, (const bf16_t*)(ws + WS_KN), (const bf16_t*)(ws + WS_VT), (const bf16_t*)(ws + WS_MK) + (size_t)l * 512 * 512, (const bf16_t*)(ws + WS_MVT) + (size_t)l * 8 * 128 * 256,
                     IN(21) + l * 64, IN(26) + l * 128, IN(23) + (size_t)l * 8 * NREL, (bf16_t*)(ws + WS_YATT), (bf16_t*)(ws + WS_YMEM)};
            const int lane = FRESH_LANE();
            if (bx < 192) {
                attn_unit(wscr, ap, bx * 8 + wave, lane);
                __syncthreads();
                ScanP sp{(const bf16_t*)(ws + WS_R), (const bf16_t*)(ws + WS_K), (const bf16_t*)(ws + WS_V), (const bf16_t*)(ws + WS_KK), (const bf16_t*)(ws + WS_BB), (const bf16_t*)(ws + WS_EW), (float*)(ws + WS_YRAW),
                         (bf16_t*)(ws + WS_SQ), (float*)(ws + WS_SMID)};
                scan_block(lds, sp, bx);
            } else {
                const int NW2 = (G - 192) * 8;
                for (int u = 1536 + (bx - 192) * 8 + wave; u < 6144; u += NW2) attn_unit(wscr, ap, u, lane);
            }
        }
        GSYNC();
        if (STOP_AT == 8 && l == STOP_LAYER) { dbg_dump(X, ws, WS_YRAW, WS_YATT, WS_YMEM, G, bx); return; }
        {
            PostP pp{(const float*)(ws + WS_YRAW), (const bf16_t*)(ws + WS_R), (const bf16_t*)(ws + WS_K), (const bf16_t*)(ws + WS_V), (const bf16_t*)(ws + WS_G),
                     IN(15) + l * RW, IN(16) + l * RW, IN(17) + l * RW, (bf16_t*)(ws + WS_YRWKV), (const bf16_t*)(ws + WS_SQ), (const float*)(ws + WS_SMID)};
            rwkv_post(pp, bx, G);
        }
        GSYNC();
        if (STOP_AT == 9 && l == STOP_LAYER) { dbg_dump(X, ws, 0, WS_YRWKV, 0, G, bx); return; }
        { pg8::Gemm g{(const bf16_t*)(ws + WS_YATT), WBR, (size_t)16 * MiB, (size_t)DM * RW * 2, MTOK, DM, RW}; pg8::StaticOrder S; S.init(MTOK, DM, G, bx, 3);
          pg8::EpiMerge E{(bf16_t*)(ws + WS_MERGEDF), (bf16_t*)(ws + WS_MERGEDB), GATES};
          pg8::gemm_phase<pg8::EpiMerge, pg8::StaticOrder>(lds, g, S, E); }
        GSYNC();
        if (STOP_AT == 10 && l == STOP_LAYER) { dbg_dump(X, ws, 0, WS_MERGEDB, WS_MERGEDB + 16 * MiB, G, bx); return; }
        { pg8::Gemm g{(const bf16_t*)(ws + WS_MERGEDB), WO, 0, 0, MTOK, DM, DM}; pg8::StaticOrder S; S.init(MTOK, DM, G, bx); pg8::EpiResid E{X, 1.0f};
          pg8::gemm_phase<pg8::EpiResid, pg8::StaticOrder>(lds, g, S, E); }
        GSYNC();
        if (STOP_AT == 11 && l == STOP_LAYER) return;
        { const int lane = FRESH_LANE(); rms_rows(X, nullptr, IN(34) + l * DM, HN, MTOK, gw, NGW, lane); }
        GSYNC();
        if (STOP_AT == 12 && l == STOP_LAYER) return;
        { pg8::Gemm g{HN, W1A, 0, 0, MTOK, 2 * DFF, DM}; pg8::StaticOrder S; S.init(MTOK, 2 * DFF, G, bx); pg8::EpiSwiglu E{ACT};
          pg8::gemm_phase<pg8::EpiSwiglu, pg8::StaticOrder>(lds, g, S, E); }
        GSYNC();
        if (STOP_AT == 13 && l == STOP_LAYER) return;
        { pg8::Gemm g{ACT, W1B, 0, 0, MTOK, DM, DFF}; pg8::StaticOrder S; S.init(MTOK, DM, G, bx); pg8::EpiResid E{X, 0.5f};
          pg8::gemm_phase<pg8::EpiResid, pg8::StaticOrder>(lds, g, S, E); }
        GSYNC();
        if (STOP_AT == 14 && l == STOP_LAYER) return;
    }
}

#undef W1A
#undef W1B
#undef WP
#undef WBR
#undef WO
#undef HN
#undef PROJ
#undef ACT
#undef GATES
#undef VRA
#undef X
#undef ws
#undef IN
extern "C" void kernel_launch(void* const* d_in, const int* in_sizes, int n_in, void* d_out, int out_size, void* d_ws, size_t ws_size, hipStream_t stream) {
    static int grid = 0;
    if (grid == 0) {
        if (n_in != 37 || ws_size < WS_END) { fprintf(stderr, "kernel_launch: unexpected n_in %d or ws_size %zu (< %zu)\n", n_in, ws_size, (size_t)WS_END); }
        int dev = 0, cus = 0, per_cu = 0;
        (void)hipGetDevice(&dev);
        (void)hipDeviceGetAttribute(&cus, hipDeviceAttributeMultiprocessorCount, dev);
        (void)hipFuncSetAttribute((const void*)mega_fwd, hipFuncAttributeMaxDynamicSharedMemorySize, LDS_BYTES);
        (void)hipOccupancyMaxActiveBlocksPerMultiprocessor(&per_cu, (const void*)mega_fwd, 512, LDS_BYTES);
        if (per_cu < 1) per_cu = 1;
        grid = cus * per_cu;
        fprintf(stderr, "kernel_launch: cus %d per_cu %d grid %d\n", cus, per_cu, grid);
    }
    if (ws_size < WS_END) return;
    (void)hipMemsetAsync(d_ws, 0, 65536, stream);
    Args a{};
    for (int i = 0; i < 37; ++i) a.in[i] = (const float*)d_in[i];
    a.out = (float*)d_out; a.ws = (unsigned char*)d_ws;
    void* args[] = {&a};
    hipError_t e = hipLaunchCooperativeKernel((const void*)mega_fwd, dim3(grid), dim3(512), args, LDS_BYTES, stream);
    if (e != hipSuccess) fprintf(stderr, "cooperative launch failed: %s (grid %d)\n", hipGetErrorString(e), grid);
}
```

```cpp
#include <hip/hip_runtime.h>
#include <hip/hip_cooperative_groups.h>
#include <cstdio>
#include <cstdint>
namespace cg = cooperative_groups;

#define LAS __attribute__((address_space(3)))
typedef unsigned short bf16_t;
typedef short bf16x8 __attribute__((ext_vector_type(8)));
typedef float f32x4 __attribute__((ext_vector_type(4)));
typedef float f32x2 __attribute__((ext_vector_type(2)));
typedef unsigned u32x4 __attribute__((ext_vector_type(4)));
typedef unsigned u32x2 __attribute__((ext_vector_type(2)));

constexpr int DM = 1024, BATCH = 2, SEQ = 8192, DEPTH = 4, MTOK = BATCH * SEQ;
constexpr int RW = 512, DFF = 2816, DIN = 3840, RWKV_IN = 1792;
constexpr int NREL = 192;
constexpr int COL_AQ = 1792, COL_AK = 2304, COL_AV = 2816, COL_MQ = 3328;
constexpr float LOG2E = 1.4426950408889634f;

constexpr size_t MiB = 1u << 20;
constexpr size_t WS_W1A = 1 * MiB;
constexpr size_t WS_W1B = 12 * MiB;
constexpr size_t WS_WP = 18 * MiB;
constexpr size_t WS_WBR = 32 * MiB;
constexpr size_t WS_WO = 35 * MiB;
constexpr size_t WS_HN = 37 * MiB;
constexpr size_t WS_PROJ = 69 * MiB;
constexpr size_t WS_GATES = 189 * MiB;
constexpr size_t WS_VRA = 285 * MiB;
constexpr size_t WS_R = 287 * MiB, WS_K = 303 * MiB, WS_V = 319 * MiB, WS_G = 335 * MiB;
constexpr size_t WS_KK = 351 * MiB, WS_BB = 367 * MiB, WS_EW = 383 * MiB;
constexpr size_t WS_YRAW = 399 * MiB;
constexpr size_t WS_KN = 431 * MiB, WS_VT = 447 * MiB;
constexpr size_t WS_VFIRST = 463 * MiB;
constexpr size_t WS_MK = 479 * MiB;
constexpr size_t WS_MVT = 481 * MiB;
constexpr size_t WS_LIN = 483 * MiB;
constexpr size_t WS_LBT = 495 * MiB;
constexpr size_t WS_END = 495 * MiB + 1536 * 1024;
constexpr size_t WS_SQ = 483 * MiB;
constexpr size_t WS_SMID = 128 * 1024;
constexpr size_t WS_LOA = 37 * MiB;
constexpr size_t WS_LOB = 399 * MiB;
constexpr size_t WS_MERGEDF = WS_KK;
constexpr size_t WS_MERGEDB = WS_R;
constexpr size_t WS_YATT = WS_HN, WS_YMEM = WS_HN + 16 * MiB, WS_YRWKV = WS_HN + 32 * MiB;
constexpr size_t WS_WMKV = WS_GATES;
constexpr size_t WS_MEMN = WS_GATES + 8 * MiB;
constexpr size_t WS_MKVRAW = WS_GATES + 12 * MiB;

constexpr int PTAB_OFF = 155648;
constexpr int LDS_BYTES = PTAB_OFF + 1024;
#define STOP_AT 0
#define DBG_A (WS_GATES + 40 * MiB)
#define DBG_B 0
#ifndef STOP_AT
#define STOP_AT 0
#endif
#ifndef STOP_LAYER
#define STOP_LAYER 0
#endif

struct Args { const float* in[37]; float* out; unsigned char* ws; };

typedef __bf16 bf16x2_t __attribute__((ext_vector_type(2)));
__device__ __forceinline__ unsigned pk2(float lo, float hi) { f32x2 v = {lo, hi}; bf16x2_t b = __builtin_convertvector(v, bf16x2_t); return __builtin_bit_cast(unsigned, b); }
__device__ __forceinline__ unsigned f2bf(float f) { return pk2(f, 0.f) & 0xffffu; }
__device__ __forceinline__ float bf2f(unsigned short b) { return __builtin_bit_cast(float, (unsigned)b << 16); }
__device__ __forceinline__ float bflo(unsigned w) { return __builtin_bit_cast(float, w << 16); }
__device__ __forceinline__ float bfhi(unsigned w) { return __builtin_bit_cast(float, w & 0xffff0000u); }
__device__ __forceinline__ float shx(float v, int o, int lane) { return __builtin_bit_cast(float, __builtin_amdgcn_ds_bpermute((lane ^ o) << 2, __builtin_bit_cast(int, v))); }
__device__ __forceinline__ float wave_sum(float v, int lane) {
#pragma unroll
    for (int o = 1; o < 64; o <<= 1) v += shx(v, o, lane);
    return v;
}
__device__ __forceinline__ float fexp2(float x) { return __builtin_amdgcn_exp2f(x); }
__device__ __forceinline__ float frcp(float x) { return __builtin_amdgcn_rcpf(x); }
__device__ __forceinline__ float sigmoidf_(float x) { return frcp(1.f + fexp2(-LOG2E * x)); }
#define LDS_WAIT() asm volatile("s_waitcnt lgkmcnt(0)" ::: "memory")
template <int CTRL> __device__ __forceinline__ float dppf(float x) { return __builtin_bit_cast(float, __builtin_amdgcn_update_dpp(0, __builtin_bit_cast(int, x), CTRL, 0xF, 0xF, true)); }
__device__ __forceinline__ float row16_sum(float x) { x += dppf<0xB1>(x); x += dppf<0x4E>(x); x += dppf<0x124>(x); x += dppf<0x128>(x); return x; }


namespace pg8 {
constexpr int BM = 256, BK = 64, HALF = 128, HTB = HALF * BK * 2, STAGE_BYTES = 8 * HTB, NXCD = 8, WGM = 8;
__host__ __device__ __forceinline__ int lds_byte(int r, int c) { const int st = (r >> 4) * 2 + (c >> 5), rr = r & 15, cc = c & 31, ob = rr * 64 + cc * 2; return st * 1024 + (ob ^ (((ob >> 9) & 1) << 5)); }
__host__ __device__ __forceinline__ void stage_rc(int b, int& R, int& C) { const int st = b / 1024, sb = b % 1024, swz = sb ^ (((sb >> 9) & 1) << 5); R = (st >> 1) * 16 + swz / 64; C = (st & 1) * 32 + (swz % 64) / 2; }
__host__ __device__ __forceinline__ int perm32(int rho) { const int n = rho >> 4, i = rho & 15; return 8 * (i >> 2) + 4 * n + (i & 3); }

struct Unit { int pm, pn, z; };
struct Gemm { const bf16_t* A; const bf16_t* Bt; size_t zA, zB; int M, N, K; };

struct StaticOrder {
    int nM, nN, nwg, G, c, nz;
    __device__ void init(int M, int N, int G_, int c_, int nz_ = 1) { nM = M / BM; nN = N / BM; nwg = nM * nN; G = G_; c = c_; nz = nz_; }
    __device__ bool next(int i, Unit& u) const {
        const int ib = i / nz; u.z = i - ib * nz;
        const long L = (long)ib * G + c; if (c < 0 || L >= nwg) return false;
        int wgid = (int)L; { const int q = nwg / NXCD, r = nwg % NXCD, xcd = wgid % NXCD, off = wgid / NXCD; wgid = (xcd < r ? xcd * (q + 1) : r * (q + 1) + (xcd - r) * q) + off; }
        const int nig = WGM * nN, gid = wgid / nig, fm = gid * WGM, gsz = (nM - fm) < WGM ? (nM - fm) : WGM;
        u.pm = fm + ((wgid % nig) % gsz); u.pn = (wgid % nig) / gsz; return true;
    }
};
struct ZOrder {
    int G, c;
    __device__ bool next(int i, Unit& u) const { const long L = (long)i * G + c; if (L >= 32) return false; u.z = (int)L >> 3; u.pm = ((int)L & 7) >> 2; u.pn = (int)L & 3; return true; }
};

__device__ __forceinline__ unsigned cvt_pk_bf16(float lo, float hi) { return pk2(lo, hi); }


struct EpiSwiglu {
    static constexpr bool PERM = true;
    bf16_t* O;
    __device__ __forceinline__ void operator()(const f32x4 (&acc)[2][2][4][2], const Unit& u, int wr, int wc, int fr, int fq) const {
        const int row0 = u.pm * BM + wr * 64 + fr, col0 = u.pn * 128 + wc * 32 + 8 * fq;
#pragma unroll
        for (int ai = 0; ai < 2; ++ai)
#pragma unroll
            for (int m = 0; m < 4; ++m) {
                bf16_t* p = O + (size_t)(row0 + ai * HALF + m * 16) * DFF + col0;
                float o[8];
#pragma unroll
                for (int n = 0; n < 2; ++n)
#pragma unroll
                    for (int i = 0; i < 4; ++i) { const float g = acc[ai][0][m][n][i], up = acc[ai][1][m][n][i]; o[n * 4 + i] = g * frcp(1.f + fexp2(-LOG2E * g)) * up; }
                u32x4 w; w.x = cvt_pk_bf16(o[0], o[1]); w.y = cvt_pk_bf16(o[2], o[3]); w.z = cvt_pk_bf16(o[4], o[5]); w.w = cvt_pk_bf16(o[6], o[7]);
                *(u32x4*)p = w;
            }
    }
};
struct EpiResid {
    static constexpr bool PERM = false;
    float* X; float s;
    __device__ __forceinline__ void operator()(const f32x4 (&acc)[2][2][4][2], const Unit& u, int wr, int wc, int fr, int fq) const {
        const int row0 = u.pm * BM + wr * 64 + fr, col0 = u.pn * BM + wc * 32 + 4 * fq;
#pragma unroll
        for (int ai = 0; ai < 2; ++ai) {
            f32x4 xv[4][2][2];
#pragma unroll
            for (int m = 0; m < 4; ++m)
#pragma unroll
                for (int bj = 0; bj < 2; ++bj)
#pragma unroll
                    for (int n = 0; n < 2; ++n) xv[m][bj][n] = *(const f32x4*)(X + (size_t)(row0 + ai * HALF + m * 16) * DM + col0 + bj * HALF + n * 16);
            asm volatile("" ::: "memory");
#pragma unroll
            for (int m = 0; m < 4; ++m)
#pragma unroll
                for (int bj = 0; bj < 2; ++bj)
#pragma unroll
                    for (int n = 0; n < 2; ++n) *(f32x4*)(X + (size_t)(row0 + ai * HALF + m * 16) * DM + col0 + bj * HALF + n * 16) = xv[m][bj][n] + acc[ai][bj][m][n] * s;
            asm volatile("" ::: "memory");
        }
    }
};
struct EpiProj {
    static constexpr bool PERM = true;
    bf16_t* P; bf16_t* G; float* VRA; const float* bgate;
    __device__ __forceinline__ void operator()(const f32x4 (&acc)[2][2][4][2], const Unit& u, int wr, int wc, int fr, int fq) const {
        const int row0 = u.pm * BM + wr * 64 + fr;
        if (u.pn < 15) {
            const int col0 = u.pn * BM + wc * 32 + 8 * fq;
#pragma unroll
            for (int ai = 0; ai < 2; ++ai)
#pragma unroll
                for (int m = 0; m < 4; ++m) { bf16_t* rp = P + (size_t)(row0 + ai * HALF + m * 16) * DIN + col0;
#pragma unroll
                    for (int bj = 0; bj < 2; ++bj) { const f32x4 v0 = acc[ai][bj][m][0], v1 = acc[ai][bj][m][1];
                        u32x4 w; w.x = cvt_pk_bf16(v0[0], v0[1]); w.y = cvt_pk_bf16(v0[2], v0[3]); w.z = cvt_pk_bf16(v1[0], v1[1]); w.w = cvt_pk_bf16(v1[2], v1[3]);
                        *(u32x4*)(rp + bj * HALF) = w; } }
        } else if (u.pn < 27) {
            const int col0 = (u.pn - 15) * BM + wc * 32 + 8 * fq;
            f32x4 bv[2][2];
#pragma unroll
            for (int bj = 0; bj < 2; ++bj)
#pragma unroll
                for (int n = 0; n < 2; ++n) bv[bj][n] = *(const f32x4*)(bgate + col0 + bj * HALF + 4 * n);
#pragma unroll
            for (int ai = 0; ai < 2; ++ai)
#pragma unroll
                for (int m = 0; m < 4; ++m) { unsigned char* rp = (unsigned char*)G + (size_t)(row0 + ai * HALF + m * 16) * 3072 + col0;
#pragma unroll
                    for (int bj = 0; bj < 2; ++bj) { f32x4 v0 = acc[ai][bj][m][0] + bv[bj][0], v1 = acc[ai][bj][m][1] + bv[bj][1];
                        unsigned q0[4], q1[4];
#pragma unroll
                        for (int i = 0; i < 4; ++i) { q0[i] = (unsigned)(sigmoidf_(v0[i]) * 255.f + 0.5f); q1[i] = (unsigned)(sigmoidf_(v1[i]) * 255.f + 0.5f); }
                        u32x2 w; w.x = q0[0] | (q0[1] << 8) | (q0[2] << 16) | (q0[3] << 24); w.y = q1[0] | (q1[1] << 8) | (q1[2] << 16) | (q1[3] << 24);
                        *(u32x2*)(rp + bj * HALF) = w; } }
        } else {
            if (wc == 0) {
#pragma unroll
                for (int ai = 0; ai < 2; ++ai)
#pragma unroll
                    for (int m = 0; m < 4; ++m) { float* rp = VRA + (size_t)(row0 + ai * HALF + m * 16) * 32 + 8 * fq;
                        *(f32x4*)rp = acc[ai][0][m][0]; *(f32x4*)(rp + 4) = acc[ai][0][m][1]; }
            }
        }
    }
};
struct EpiMerge {
    static constexpr bool PERM = true;
    bf16_t* Mp; bf16_t* Mb; const bf16_t* G;
    __device__ __forceinline__ void operator()(const f32x4 (&acc)[2][2][4][2], const Unit& u, int wr, int wc, int fr, int fq) const {
        const int row0 = u.pm * BM + wr * 64 + fr, col0 = u.pn * BM + wc * 32 + 8 * fq;
        const int z = u.z, goff = (z == 2 ? 0 : (z + 1) * 1024);
        bf16_t* dst = (z == 2) ? Mb : Mp;
#pragma unroll
        for (int ai = 0; ai < 2; ++ai) {
            u32x2 gv[4][2]; u32x4 pv[4][2];
#pragma unroll
            for (int m = 0; m < 4; ++m)
#pragma unroll
                for (int bj = 0; bj < 2; ++bj) { const size_t row = (size_t)(row0 + ai * HALF + m * 16); const int c = col0 + bj * HALF;
                    gv[m][bj] = *(const u32x2*)((const unsigned char*)G + row * 3072 + goff + c);
                    pv[m][bj] = (z != 0) ? *(const u32x4*)(Mp + row * DM + c) : (u32x4){0u, 0u, 0u, 0u}; }
            asm volatile("" ::: "memory");
#pragma unroll
            for (int m = 0; m < 4; ++m)
#pragma unroll
                for (int bj = 0; bj < 2; ++bj) { const size_t row = (size_t)(row0 + ai * HALF + m * 16); const int c = col0 + bj * HALF;
                    const u32x2 g2 = gv[m][bj]; const u32x4 p4 = pv[m][bj];
                    const f32x4 v0s = acc[ai][bj][m][0] * (1.f / 255.f), v1s = acc[ai][bj][m][1] * (1.f / 255.f);
                    f32x4 v0, v1;
                    v0[0] = v0s[0] * (float)(g2.x & 0xffu) + bflo(p4.x); v0[1] = v0s[1] * (float)((g2.x >> 8) & 0xffu) + bfhi(p4.x);
                    v0[2] = v0s[2] * (float)((g2.x >> 16) & 0xffu) + bflo(p4.y); v0[3] = v0s[3] * (float)(g2.x >> 24) + bfhi(p4.y);
                    v1[0] = v1s[0] * (float)(g2.y & 0xffu) + bflo(p4.z); v1[1] = v1s[1] * (float)((g2.y >> 8) & 0xffu) + bfhi(p4.z);
                    v1[2] = v1s[2] * (float)((g2.y >> 16) & 0xffu) + bflo(p4.w); v1[3] = v1s[3] * (float)(g2.y >> 24) + bfhi(p4.w);
                    u32x4 w; w.x = cvt_pk_bf16(v0[0], v0[1]); w.y = cvt_pk_bf16(v0[2], v0[3]); w.z = cvt_pk_bf16(v1[0], v1[1]); w.w = cvt_pk_bf16(v1[2], v1[3]);
                    *(u32x4*)(dst + row * DM + c) = w; }
            asm volatile("" ::: "memory");
        }
    }
};
struct EpiPlain {
    static constexpr bool PERM = true;
    bf16_t* O; int ldc; size_t zO;
    __device__ __forceinline__ void operator()(const f32x4 (&acc)[2][2][4][2], const Unit& u, int wr, int wc, int fr, int fq) const {
        const int row0 = u.pm * BM + wr * 64 + fr, col0 = u.pn * BM + wc * 32 + 8 * fq;
        bf16_t* base = O + (size_t)u.z * zO;
#pragma unroll
        for (int ai = 0; ai < 2; ++ai)
#pragma unroll
            for (int m = 0; m < 4; ++m) { bf16_t* rp = base + (size_t)(row0 + ai * HALF + m * 16) * ldc + col0;
#pragma unroll
                for (int bj = 0; bj < 2; ++bj) { const f32x4 v0 = acc[ai][bj][m][0], v1 = acc[ai][bj][m][1];
                    u32x4 w; w.x = cvt_pk_bf16(v0[0], v0[1]); w.y = cvt_pk_bf16(v0[2], v0[3]); w.z = cvt_pk_bf16(v1[0], v1[1]); w.w = cvt_pk_bf16(v1[2], v1[3]);
                    *(u32x4*)(rp + bj * HALF) = w; } }
    }
};

struct EpiSplit2 {
    static constexpr bool PERM = true;
    bf16_t* O0; bf16_t* O1;
    __device__ __forceinline__ void operator()(const f32x4 (&acc)[2][2][4][2], const Unit& u, int wr, int wc, int fr, int fq) const {
        const int row0 = u.pm * BM + wr * 64 + fr, col0 = (u.pn & 3) * BM + wc * 32 + 8 * fq;
        bf16_t* base = (u.pn < 4) ? O0 : O1;
#pragma unroll
        for (int ai = 0; ai < 2; ++ai)
#pragma unroll
            for (int m = 0; m < 4; ++m) { bf16_t* rp = base + (size_t)(row0 + ai * HALF + m * 16) * 1024 + col0;
#pragma unroll
                for (int bj = 0; bj < 2; ++bj) { const f32x4 v0 = acc[ai][bj][m][0], v1 = acc[ai][bj][m][1];
                    u32x4 w; w.x = cvt_pk_bf16(v0[0], v0[1]); w.y = cvt_pk_bf16(v0[2], v0[3]); w.z = cvt_pk_bf16(v1[0], v1[1]); w.w = cvt_pk_bf16(v1[2], v1[3]);
                    *(u32x4*)(rp + bj * HALF) = w; } }
    }
};
template <class Epi, class Sched>
__device__ __forceinline__ void gemm_phase(LAS unsigned char* lds, const Gemm g, const Sched& S, const Epi& E) {
    int tid_ = threadIdx.x; asm volatile("" : "+v"(tid_));
    const int tid = tid_, wid = __builtin_amdgcn_readfirstlane(tid >> 6), lane = tid & 63, wr = wid >> 2, wc = wid & 3, fr = lane & 15, fq = lane >> 4;
    int K_ = g.K; asm volatile("" : "+s"(K_));
    const int K = K_, nt = K / BK;
    unsigned voffA[2], voffB[2];
#pragma unroll
    for (int i = 0; i < 2; ++i) { int R, C; stage_rc(tid * 16 + i * 8192, R, C); const int Rb = Epi::PERM ? ((R & ~31) + perm32(R & 31)) : R;
        voffA[i] = (unsigned)(R * K + C) * 2u; voffB[i] = (unsigned)(Rb * K + C) * 2u; }
    const size_t kstep = (size_t)(BK * 2);
    const size_t hstep = (size_t)HALF * K * 2;
    const size_t tstep = 2 * hstep;
    const unsigned ldsw = (unsigned)wid * 1024u;
    const int aoff = lds_byte(wr * 64 + fr, fq * 8), boff = lds_byte(wc * 32 + fr, fq * 8);
#define PG8_SA(b, h) (((b) * 2 + (h)) * HTB)
#define PG8_SB(b, h) ((4 + (b) * 2 + (h)) * HTB)
#define PG8_STAGE(bufoff, gbase, voff) do { _Pragma("unroll") for (int _i = 0; _i < 2; ++_i) \
        __builtin_amdgcn_global_load_lds((const unsigned*)((const char*)(gbase) + (voff)[_i]), (LAS unsigned*)(lds + (bufoff) + ldsw + _i * 8192), 16, 0, 0); } while (0)
#define PG8_LDA(dst, b, h) do { _Pragma("unroll") for (int m = 0; m < 4; ++m) _Pragma("unroll") for (int k = 0; k < 2; ++k) dst[m][k] = *(const LAS bf16x8*)(lds + PG8_SA(b, h) + aoff + m * 2048 + k * 1024); } while (0)
#define PG8_LDB(dst, b, h) do { _Pragma("unroll") for (int n = 0; n < 2; ++n) _Pragma("unroll") for (int k = 0; k < 2; ++k) dst[n][k] = *(const LAS bf16x8*)(lds + PG8_SB(b, h) + boff + n * 2048 + k * 1024); } while (0)
#define PG8_MMA(ai, bj, At, Bt) do { __builtin_amdgcn_s_setprio(1); _Pragma("unroll") for (int m = 0; m < 4; ++m) _Pragma("unroll") for (int n = 0; n < 2; ++n) _Pragma("unroll") for (int k = 0; k < 2; ++k) \
        acc[ai][bj][m][n] = __builtin_amdgcn_mfma_f32_16x16x32_bf16(Bt[n][k], At[m][k], acc[ai][bj][m][n], 0, 0, 0); __builtin_amdgcn_s_setprio(0); } while (0)
#define PG8_WAIT_V(n) asm volatile("s_waitcnt vmcnt(" #n ")" ::: "memory")
#define PG8_WAIT_L(n) asm volatile("s_waitcnt lgkmcnt(" #n ")" ::: "memory")
#define PG8_BAR __builtin_amdgcn_s_barrier()
#define PG8_SCHED __builtin_amdgcn_sched_barrier(0)
    Unit cur, nxt; int ui = 0;
    if (S.next(0, cur)) {
    f32x4 acc[2][2][4][2];
#pragma unroll
    for (int a = 0; a < 2; ++a)
#pragma unroll
        for (int b = 0; b < 2; ++b)
#pragma unroll
            for (int m = 0; m < 4; ++m)
#pragma unroll
                for (int n = 0; n < 2; ++n) acc[a][b][m][n] = (f32x4){0.f, 0.f, 0.f, 0.f};
    bf16x8 At[4][2], B0[2][2], B1[2][2];
    const char* cA = (const char*)g.A + (size_t)cur.z * g.zA + (size_t)cur.pm * tstep; const char* cB = (const char*)g.Bt + (size_t)cur.z * g.zB + (size_t)cur.pn * tstep;
    PG8_STAGE(PG8_SB(0, 0), cB, voffB); PG8_STAGE(PG8_SB(0, 1), cB + hstep, voffB); PG8_STAGE(PG8_SA(0, 0), cA, voffA); PG8_STAGE(PG8_SA(0, 1), cA + hstep, voffA);
    if (wr == 1) PG8_BAR;
    PG8_WAIT_V(2); PG8_BAR;
    PG8_STAGE(PG8_SB(1, 0), cB + kstep, voffB); PG8_STAGE(PG8_SA(1, 0), cA + kstep, voffA); PG8_STAGE(PG8_SB(1, 1), cB + hstep + kstep, voffB);
    PG8_WAIT_V(6); PG8_BAR;
    for (;;) {
        const bool has_next = S.next(ui + 1, nxt);
        const char* nA = has_next ? (const char*)g.A + (size_t)nxt.z * g.zA + (size_t)nxt.pm * tstep : cA; const char* nB = has_next ? (const char*)g.Bt + (size_t)nxt.z * g.zB + (size_t)nxt.pn * tstep : cB;
        for (int t = 0; t < nt; t += 2) {
            const bool last = (t == nt - 2);
            const char* a1 = cA + (size_t)(t + 1) * kstep;
            const char* a2 = last ? nA : cA + (size_t)(t + 2) * kstep; const char* b2 = last ? nB : cB + (size_t)(t + 2) * kstep;
            const char* a3 = a2 + kstep; const char* b3 = b2 + kstep;
            PG8_LDB(B0, 0, 0); PG8_LDB(B1, 0, 1); PG8_SCHED; PG8_LDA(At, 0, 0); PG8_STAGE(PG8_SA(1, 1), a1 + hstep, voffA);
            PG8_WAIT_V(8); PG8_WAIT_L(0); PG8_BAR; PG8_MMA(0, 0, At, B0); PG8_MMA(0, 1, At, B1); PG8_BAR; PG8_SCHED;
            PG8_LDA(At, 0, 1); PG8_STAGE(PG8_SB(0, 0), b2, voffB); PG8_STAGE(PG8_SB(0, 1), b2 + hstep, voffB); PG8_STAGE(PG8_SA(0, 0), a2, voffA);
            PG8_WAIT_V(8); PG8_WAIT_L(0); PG8_BAR; PG8_MMA(1, 0, At, B0); PG8_MMA(1, 1, At, B1); PG8_BAR; PG8_SCHED;
            PG8_LDB(B0, 1, 0); PG8_LDB(B1, 1, 1); PG8_SCHED; PG8_LDA(At, 1, 0); PG8_STAGE(PG8_SA(0, 1), a2 + hstep, voffA);
            PG8_WAIT_V(8); PG8_WAIT_L(0); PG8_BAR; PG8_MMA(0, 0, At, B0); PG8_MMA(0, 1, At, B1); PG8_BAR; PG8_SCHED;
            PG8_LDA(At, 1, 1); PG8_STAGE(PG8_SB(1, 0), b3, voffB); PG8_STAGE(PG8_SB(1, 1), b3 + hstep, voffB); PG8_STAGE(PG8_SA(1, 0), a3, voffA);
            PG8_WAIT_V(8); PG8_WAIT_L(0); PG8_BAR; PG8_MMA(1, 0, At, B0); PG8_MMA(1, 1, At, B1); PG8_BAR; PG8_SCHED;
        }
        if (wr == 0) PG8_BAR;
        E(acc, cur, wr, wc, fr, fq);
        if (!has_next) break;
#pragma unroll
        for (int a = 0; a < 2; ++a)
#pragma unroll
            for (int b = 0; b < 2; ++b)
#pragma unroll
                for (int m = 0; m < 4; ++m)
#pragma unroll
                    for (int n = 0; n < 2; ++n) acc[a][b][m][n] = (f32x4){0.f, 0.f, 0.f, 0.f};
        cur = nxt; cA = nA; cB = nB; ++ui;
        if (wr == 1) PG8_BAR;
    }
    PG8_WAIT_V(0);
    PG8_BAR;
    }
#undef PG8_SA
#undef PG8_SB
#undef PG8_STAGE
#undef PG8_LDA
#undef PG8_LDB
#undef PG8_MMA
#undef PG8_WAIT_V
#undef PG8_WAIT_L
#undef PG8_BAR
#undef PG8_SCHED
}
}

__device__ __forceinline__ void tr_item(const float* __restrict__ W, int K, int N, bf16_t* WT, int mode, int row_off, LAS float* scr, int item, int lane) {
    const int nblk = N / 32, kb = item / nblk, nb = item - kb * nblk, k0 = 64 * kb, n0 = 32 * nb;
#pragma unroll 8
    for (int i = 0; i < 32; ++i) { const int kk = 2 * i + (lane >> 5); scr[kk * 33 + (lane & 31)] = W[(size_t)(k0 + kk) * N + n0 + (lane & 31)]; }
    LDS_WAIT(); asm volatile("" ::: "memory");
    int d0;
    if (mode == 1) { const int j = n0 < DFF ? n0 : n0 - DFF; d0 = 256 * (j >> 7) + (j & 127) + (n0 < DFF ? 0 : 128); }
    else d0 = row_off + n0;
    const int c = lane & 7;
#pragma unroll
    for (int j = 0; j < 4; ++j) { const int n = (lane >> 3) + 8 * j; const LAS float* s = scr + (8 * c) * 33 + n;
        u32x4 o; o.x = pk2(s[0 * 33], s[1 * 33]); o.y = pk2(s[2 * 33], s[3 * 33]); o.z = pk2(s[4 * 33], s[5 * 33]); o.w = pk2(s[6 * 33], s[7 * 33]);
        *(u32x4*)(WT + (size_t)(d0 + n) * K + k0 + 8 * c) = o; }
    LDS_WAIT(); asm volatile("" ::: "memory");
}
__device__ __forceinline__ void tr_job(const float* W, bf16_t* WT, int K, int N, int mode, int row_off, int& base, LAS float* scr, int gw, int NGW, int lane) {
    const int items = (K / 64) * (N / 32);
    int first = gw - (base % NGW); if (first < 0) first += NGW;
    for (int it = first; it < items; it += NGW) tr_item(W, K, N, WT, mode, row_off, scr, it, lane);
    base += items;
}

__device__ __forceinline__ void rms_rows(const float* X, float* Xcopy, const float* gain, bf16_t* out, int nrows, int gw, int NGW, int lane) {
    f32x4 gv[4];
#pragma unroll
    for (int j = 0; j < 4; ++j) gv[j] = *(const f32x4*)(gain + 4 * lane + 256 * j);
    for (int m = gw; m < nrows; m += NGW) {
        const float* xr = X + (size_t)m * DM + 4 * lane;
        f32x4 v[4]; float s = 0.f;
#pragma unroll
        for (int j = 0; j < 4; ++j) { v[j] = *(const f32x4*)(xr + 256 * j); s += (v[j].x * v[j].x + v[j].y * v[j].y) + (v[j].z * v[j].z + v[j].w * v[j].w); }
        const float sc = 1.0f / sqrtf(wave_sum(s, lane) * (1.f / DM) + 1e-6f);
        bf16_t* orow = out + (size_t)m * DM + 4 * lane;
#pragma unroll
        for (int j = 0; j < 4; ++j) { u32x2 w; w.x = pk2(v[j].x * sc * gv[j].x, v[j].y * sc * gv[j].y); w.y = pk2(v[j].z * sc * gv[j].z, v[j].w * sc * gv[j].w); *(u32x2*)(orow + 256 * j) = w; }
        if (Xcopy) {
#pragma unroll
            for (int j = 0; j < 4; ++j) *(f32x4*)(Xcopy + (size_t)m * DM + 4 * lane + 256 * j) = v[j];
        }
    }
}

__device__ __forceinline__ void mem_post_row(const bf16_t* raw, bf16_t* MK, bf16_t* MVT, const float* kgain, int row, int lane) {
    const u32x4 kv = *(const u32x4*)(raw + (size_t)row * 1024 + 8 * lane);
    float v[8] = {bflo(kv.x), bfhi(kv.x), bflo(kv.y), bfhi(kv.y), bflo(kv.z), bfhi(kv.z), bflo(kv.w), bfhi(kv.w)};
    float ss = 0.f;
#pragma unroll
    for (int j = 0; j < 8; ++j) ss += v[j] * v[j];
    ss += shx(ss, 1, lane); ss += shx(ss, 2, lane); ss += shx(ss, 4, lane); ss += shx(ss, 8, lane);
    const float sc = 1.0f / sqrtf(ss * (1.f / 128.f) + 1e-6f);
    const int gc = (8 * lane) & 127;
    u32x4 o; o.x = pk2(v[0] * sc * kgain[gc + 0], v[1] * sc * kgain[gc + 1]); o.y = pk2(v[2] * sc * kgain[gc + 2], v[3] * sc * kgain[gc + 3]);
    o.z = pk2(v[4] * sc * kgain[gc + 4], v[5] * sc * kgain[gc + 5]); o.w = pk2(v[6] * sc * kgain[gc + 6], v[7] * sc * kgain[gc + 7]);
    *(u32x4*)(MK + (size_t)row * 512 + 8 * lane) = o;
    const int b = row >> 8, key = row & 255;
    const u32x4 vv = *(const u32x4*)(raw + (size_t)row * 1024 + 512 + 8 * lane);
    const unsigned wv[4] = {vv.x, vv.y, vv.z, vv.w};
#pragma unroll
    for (int j = 0; j < 8; ++j) { const int col = 8 * lane + j, hm = col >> 7, d = col & 127;
        MVT[((size_t)(b * 4 + hm) * 128 + d) * 256 + key] = (bf16_t)((j & 1) ? (wv[j >> 1] >> 16) : (wv[j >> 1] & 0xffffu)); }
}

constexpr int TT = 8;
struct PrepP {
    const bf16_t* P; const float* VRAp;
    const float *mu, *w0, *decay_b, *a0, *iclr_b, *gate_b, *k_k, *k_a, *v0, *vres_b, *akn;
    bf16_t *R, *K, *V, *G, *KK, *BB, *EW, *VF, *KN, *VT, *LIN, *LBT; const bf16_t *LOA, *LOB;
    int use_vres;
};
__device__ __forceinline__ void lora_bt_build(const PrepP& p, int gtid, int ngt) {
    for (int idx = gtid; idx < 2048 * 48; idx += ngt) {
        const int n = idx & 2047, j = idx >> 11, k0 = 8 * j, q = n >> 9, c = n & 511;
        const float* src = nullptr;
        if (q == 0 && k0 < 64) src = p.decay_b + (size_t)k0 * RW + c;
        else if (q == 1 && k0 >= 64 && k0 < 128) src = p.iclr_b + (size_t)(k0 - 64) * RW + c;
        else if (q == 2 && k0 >= 128 && k0 < 256) src = p.gate_b + (size_t)(k0 - 128) * RW + c;
        else if (q == 3 && k0 >= 256 && k0 < 288 && p.use_vres) src = p.vres_b + (size_t)(k0 - 256) * RW + c;
        u32x4 o = {0u, 0u, 0u, 0u};
        if (src) { o.x = pk2(src[0], src[RW]); o.y = pk2(src[2 * RW], src[3 * RW]); o.z = pk2(src[4 * RW], src[5 * RW]); o.w = pk2(src[6 * RW], src[7 * RW]); }
        *(u32x4*)(p.LBT + (size_t)n * 384 + k0) = o;
    }
}
__device__ __forceinline__ void prepA(const PrepP& p, int bx, int G) {
    int tid_ = threadIdx.x; asm volatile("" : "+v"(tid_));
    const int tid = tid_, lane = tid & 63, wave = tid >> 6;
    for (int idx = bx * 512 + tid; idx < MTOK * 48; idx += G * 512) {
        const int t = idx / 48, j = idx - t * 48;
        u32x4 o = {0u, 0u, 0u, 0u};
        if (j < 32) {
            const int col = 1536 + 8 * j;
            const u32x4 cu = *(const u32x4*)(p.P + (size_t)t * DIN + col);
            u32x4 pv = {0u, 0u, 0u, 0u};
            if ((t % SEQ) != 0) pv = *(const u32x4*)(p.P + (size_t)(t - 1) * DIN + col);
            const f32x4 m0 = *(const f32x4*)(p.mu + col), m1 = *(const f32x4*)(p.mu + col + 4);
            float x[8] = {bflo(cu.x), bfhi(cu.x), bflo(cu.y), bfhi(cu.y), bflo(cu.z), bfhi(cu.z), bflo(cu.w), bfhi(cu.w)};
            const float y[8] = {bflo(pv.x), bfhi(pv.x), bflo(pv.y), bfhi(pv.y), bflo(pv.z), bfhi(pv.z), bflo(pv.w), bfhi(pv.w)};
            const float mm[8] = {m0.x, m0.y, m0.z, m0.w, m1.x, m1.y, m1.z, m1.w};
#pragma unroll
            for (int i = 0; i < 8; ++i) { float v = x[i] + (y[i] - x[i]) * mm[i];
                if (j < 8) { const float e = fexp2(2.f * LOG2E * v); v = 1.f - 2.f * frcp(e + 1.f); }
                else if (j >= 16) v = sigmoidf_(v);
                x[i] = v; }
            o.x = pk2(x[0], x[1]); o.y = pk2(x[2], x[3]); o.z = pk2(x[4], x[5]); o.w = pk2(x[6], x[7]);
        } else if (j < 36 && p.use_vres) {
            const f32x4 a = *(const f32x4*)(p.VRAp + (size_t)t * 32 + 8 * (j - 32)), b = *(const f32x4*)(p.VRAp + (size_t)t * 32 + 8 * (j - 32) + 4);
            o.x = pk2(a.x, a.y); o.y = pk2(a.z, a.w); o.z = pk2(b.x, b.y); o.w = pk2(b.z, b.w);
        }
        *(u32x4*)(p.LIN + (size_t)t * 384 + 8 * j) = o;
    }
    {
        const int h = wave, col = lane & 15, quad = lane >> 4, ch0 = h * 64 + 4 * col;
        const f32x4 akn = *(const f32x4*)(p.akn + 4 * col);
        for (int tile = bx; tile < MTOK / 16; tile += G) {
            const int tq = tile * 16 + 4 * quad, bb_ = tq / SEQ, tpos = tq % SEQ;
            u32x2 vr[4];
#pragma unroll
            for (int i = 0; i < 4; ++i) {
                const bf16_t* q = p.P + (size_t)(tq + i) * DIN;
                const u32x2 kw = *(const u32x2*)(q + COL_AK + ch0);
                const f32x4 ak = {bflo(kw.x), bfhi(kw.x), bflo(kw.y), bfhi(kw.y)};
                const float ss = row16_sum((ak.x * ak.x + ak.y * ak.y) + (ak.z * ak.z + ak.w * ak.w));
                const f32x4 kn = ak * (__builtin_amdgcn_rsqf(ss * (1.f / 64.f) + 1e-6f)) * akn;
                u32x2 w; w.x = pk2(kn.x, kn.y); w.y = pk2(kn.z, kn.w);
                *(u32x2*)(p.KN + (size_t)(tq + i) * RW + ch0) = w;
                vr[i] = *(const u32x2*)(q + COL_AV + ch0);
            }
            bf16_t* vbase = p.VT + ((size_t)(bb_ * 8 + h) * 64 + 4 * col) * SEQ + tpos;
            u32x2 o0, o1, o2, o3;
            o0.x = (vr[0].x & 0xffffu) | (vr[1].x << 16);  o0.y = (vr[2].x & 0xffffu) | (vr[3].x << 16);
            o1.x = (vr[0].x >> 16) | (vr[1].x & 0xffff0000u); o1.y = (vr[2].x >> 16) | (vr[3].x & 0xffff0000u);
            o2.x = (vr[0].y & 0xffffu) | (vr[1].y << 16);  o2.y = (vr[2].y & 0xffffu) | (vr[3].y << 16);
            o3.x = (vr[0].y >> 16) | (vr[1].y & 0xffff0000u); o3.y = (vr[2].y >> 16) | (vr[3].y & 0xffff0000u);
            *(u32x2*)vbase = o0; *(u32x2*)(vbase + SEQ) = o1; *(u32x2*)(vbase + 2 * SEQ) = o2; *(u32x2*)(vbase + 3 * SEQ) = o3;
        }
    }
}
__device__ __forceinline__ f32x4 bf4(u32x2 w) { return (f32x4){bflo(w.x), bfhi(w.x), bflo(w.y), bfhi(w.y)}; }
__device__ __forceinline__ u32x2 pk4(f32x4 v) { u32x2 w; w.x = pk2(v.x, v.y); w.y = pk2(v.z, v.w); return w; }
__device__ __forceinline__ void prepB(const PrepP& p, int bx, int G) {
    int tid_ = threadIdx.x; asm volatile("" : "+v"(tid_));
    const int lane = tid_ & 63, h = tid_ >> 6, col = lane & 15, quad = lane >> 4;
    const int ch0 = h * 64 + 4 * col;
    const f32x4 mu_r = *(const f32x4*)(p.mu + ch0), mu_k = *(const f32x4*)(p.mu + 512 + ch0), mu_v = *(const f32x4*)(p.mu + 1024 + ch0);
    const f32x4 w0c = *(const f32x4*)(p.w0 + ch0), a0c = *(const f32x4*)(p.a0 + ch0), kkc = *(const f32x4*)(p.k_k + ch0), kac = *(const f32x4*)(p.k_a + ch0);
    const f32x4 v0c = p.use_vres ? *(const f32x4*)(p.v0 + ch0) : (f32x4){0.f, 0.f, 0.f, 0.f};
    for (int tile = bx; tile < MTOK / 16; tile += G) {
        const int tq = tile * 16 + 4 * quad;
        f32x4 pr_prev = {0.f, 0.f, 0.f, 0.f}, pk_prev = pr_prev, pv_prev = pr_prev;
        if ((tq % SEQ) != 0) { const bf16_t* q = p.P + (size_t)(tq - 1) * DIN + ch0;
            pr_prev = bf4(*(const u32x2*)q); pk_prev = bf4(*(const u32x2*)(q + 512)); pv_prev = bf4(*(const u32x2*)(q + 1024)); }
#pragma unroll
        for (int i = 0; i < 4; ++i) {
            const size_t t = (size_t)(tq + i);
            const bf16_t* q = p.P + t * DIN + ch0;
            const f32x4 pr = bf4(*(const u32x2*)q), pk = bf4(*(const u32x2*)(q + 512)), pv = bf4(*(const u32x2*)(q + 1024));
            const f32x4 dw = bf4(*(const u32x2*)(p.LOA + t * 1024 + ch0)), da = bf4(*(const u32x2*)(p.LOA + t * 1024 + 512 + ch0));
            const f32x4 dg = bf4(*(const u32x2*)(p.LOB + t * 1024 + ch0)), dv = bf4(*(const u32x2*)(p.LOB + t * 1024 + 512 + ch0));
            const f32x4 r = pr + (pr_prev - pr) * mu_r, k = pk + (pk_prev - pk) * mu_k; f32x4 v = pv + (pv_prev - pv) * mu_v;
            pr_prev = pr; pk_prev = pk; pv_prev = pv;
            f32x4 ew, a;
#pragma unroll
            for (int e = 0; e < 4; ++e) { const float zz = -(w0c[e] + dw[e]);
                const float sp = fmaxf(zz, 0.f) + __logf(1.f + __expf(-fabsf(zz)));
                ew[e] = __expf(-sp - 0.5f); a[e] = sigmoidf_(a0c[e] + da[e]); }
            if (p.use_vres) { const f32x4 vf = bf4(*(const u32x2*)(p.VF + t * RW + ch0));
#pragma unroll
                for (int e = 0; e < 4; ++e) v[e] = v[e] + (vf[e] - v[e]) * sigmoidf_(v0c[e] + dv[e]); }
            else *(u32x2*)(p.VF + t * RW + ch0) = pk4(v);
            f32x4 kk = k * kkc;
            const float ss = row16_sum((kk.x * kk.x + kk.y * kk.y) + (kk.z * kk.z + kk.w * kk.w));
            kk = kk * __builtin_amdgcn_rsqf(fmaxf(ss, 1e-24f));
            const f32x4 k2 = k * (1.f + (a - 1.f) * kac);
            const size_t o = t * RW + ch0;
            *(u32x2*)(p.R + o) = pk4(r); *(u32x2*)(p.K + o) = pk4(k2); *(u32x2*)(p.V + o) = pk4(v); *(u32x2*)(p.G + o) = pk4(dg);
            *(u32x2*)(p.KK + o) = pk4(kk); *(u32x2*)(p.BB + o) = pk4(kk * a); *(u32x2*)(p.EW + o) = pk4(ew);
        }
    }
}


constexpr int SC = 32;
struct ScanP { const bf16_t *R, *K, *V, *KK, *BB, *EW; float* Y; bf16_t* Q; float* SMID; };
constexpr int SEGT = SEQ / 2;
__device__ __forceinline__ void scan_block(LAS unsigned char* lds8, const ScanP& p, int sb) {
    int tid_ = threadIdx.x; asm volatile("" : "+v"(tid_));
    const int tid = tid_, lane = tid & 63, wave = __builtin_amdgcn_readfirstlane(tid >> 6);
    const int bh = sb / 12, jb = sb - bh * 12, b = bh >> 3, h = bh & 7, seg = jb >= 4 ? 1 : 0, oc = seg ? jb - 4 : 0;
    const int base16 = seg ? 16 * (oc >> 1) : 16 * jb;
    const int loc0 = seg ? 8 * (oc & 1) : 0;
    LAS float* lds = (LAS float*)lds8;
    constexpr int STG = 5 * 2048 + 512;
    LAS float* YP = lds + 2 * STG;
    const size_t rowbase = (size_t)b * SEQ + (size_t)seg * SEGT;
    constexpr int NCH = SEGT / SC;
    if (wave >= 4) {
        const int t = tid - 256, ls = t >> 3, c8 = (t & 7) * 8, vi = t & 7;
        const bool hsel = vi >= 4; const int h0 = hsel ? 4 : 0;
        const int colq = h * 64 + c8, colvl = h * 64 + base16 + 2 * vi;
        const int colA = h * 64 + (seg ? 8 * oc : 16 * jb) + vi, colB = h * 64 + (seg ? 8 * oc : 16 * jb + 8) + vi;
        struct LSet { u32x4 ew, r, k, kk, bb; unsigned v; };
        LSet A, B;
#define SCAN_LOAD(S_, ch) do { const size_t ro = (rowbase + (size_t)(ch) * SC + ls) * RW; \
        S_.ew = *(const u32x4*)(p.EW + ro + colq); S_.r = *(const u32x4*)(p.R + ro + colq); S_.k = *(const u32x4*)(p.K + ro + colq); \
        S_.kk = *(const u32x4*)(p.KK + ro + colq); S_.bb = *(const u32x4*)(p.BB + ro + colq); S_.v = *(const unsigned*)(p.V + ro + colvl); } while (0)
#define SCAN_ST8(off, g) do { const f32x4 lo_ = (f32x4){bflo(g.x), bfhi(g.x), bflo(g.y), bfhi(g.y)}, hi_ = (f32x4){bflo(g.z), bfhi(g.z), bflo(g.w), bfhi(g.w)}; \
        *(LAS f32x4*)(sg + (off) + o + h0) = hsel ? hi_ : lo_; *(LAS f32x4*)(sg + (off) + o + 4 - h0) = hsel ? lo_ : hi_; } while (0)
#define SCAN_STORE(S_, st) do { LAS float* sg = lds + (st) * STG; const int o = ls * 64 + c8; \
        { const f32x4 lo_ = (f32x4){__expf(-bflo(S_.ew.x)), __expf(-bfhi(S_.ew.x)), __expf(-bflo(S_.ew.y)), __expf(-bfhi(S_.ew.y))}; \
          const f32x4 hi_ = (f32x4){__expf(-bflo(S_.ew.z)), __expf(-bfhi(S_.ew.z)), __expf(-bflo(S_.ew.w)), __expf(-bfhi(S_.ew.w))}; \
          *(LAS f32x4*)(sg + o + h0) = hsel ? hi_ : lo_; *(LAS f32x4*)(sg + o + 4 - h0) = hsel ? lo_ : hi_; } \
        SCAN_ST8(2048, S_.k); SCAN_ST8(4096, S_.kk); SCAN_ST8(6144, S_.bb); SCAN_ST8(8192, S_.r); \
        *(LAS f32x2*)(sg + 10240 + ls * 16 + 2 * vi) = (f32x2){bflo(S_.v), bfhi(S_.v)}; } while (0)
#define SCAN_YRED(stq, chq) do { float ya, yb; \
        { const LAS f32x4* yp = (const LAS f32x4*)(YP + (stq) * 8192 + (ls * 16 + vi) * 16); \
          const f32x4 a0 = yp[ls & 3], a1 = yp[(ls + 1) & 3], a2 = yp[(ls + 2) & 3], a3 = yp[(ls + 3) & 3]; const f32x4 sa_ = (a0 + a1) + (a2 + a3); ya = (sa_.x + sa_.y) + (sa_.z + sa_.w); } \
        { const LAS f32x4* yp = (const LAS f32x4*)(YP + (stq) * 8192 + (ls * 16 + 8 + vi) * 16); \
          const f32x4 a0 = yp[ls & 3], a1 = yp[(ls + 1) & 3], a2 = yp[(ls + 2) & 3], a3 = yp[(ls + 3) & 3]; const f32x4 sa_ = (a0 + a1) + (a2 + a3); yb = (sa_.x + sa_.y) + (sa_.z + sa_.w); } \
        const size_t tok_ = rowbase + (size_t)(chq) * SC + ls; \
        p.Y[tok_ * RW + colA] = ya; \
        if (seg) p.Q[((size_t)b * SEGT + (size_t)(chq) * SC + ls) * RW + colB] = (bf16_t)f2bf(yb); else p.Y[tok_ * RW + colB] = yb; } while (0)
        SCAN_LOAD(A, 0); SCAN_STORE(A, 0); SCAN_LOAD(A, 1); SCAN_LOAD(B, 2);
        __syncthreads();
        for (int ch = 0; ch < NCH; ch += 2) {
            SCAN_STORE(A, 1);
            if (ch + 3 < NCH) SCAN_LOAD(A, ch + 3);
            if (ch >= 1) { SCAN_YRED(1, ch - 1); }
            __syncthreads();
            if (ch + 2 < NCH) SCAN_STORE(B, 0);
            if (ch + 4 < NCH) SCAN_LOAD(B, ch + 4);
            SCAN_YRED(0, ch);
            __syncthreads();
        }
        { SCAN_YRED(1, NCH - 1); }
#undef SCAN_LOAD
#undef SCAN_ST8
#undef SCAN_STORE
#undef SCAN_YRED
    } else {
        const int rg = lane >> 4, kq = lane & 15, lrow = 4 * wave + rg;
        const bool probe = seg && lrow >= 8;
        const int vrow = seg ? loc0 + (lrow & 7) : lrow, pidx = 8 * oc + (lrow & 7);
        const float vm = probe ? 0.f : 1.f;
        f32x2 S01 = {0.f, 0.f}, S23 = {0.f, 0.f};
        if (probe) { S01.x = (4 * kq + 0 == pidx) ? 1.f : 0.f; S01.y = (4 * kq + 1 == pidx) ? 1.f : 0.f; S23.x = (4 * kq + 2 == pidx) ? 1.f : 0.f; S23.y = (4 * kq + 3 == pidx) ? 1.f : 0.f; }
        __syncthreads();
        for (int ch = 0; ch < NCH; ++ch) {
            const int st = ch & 1;
            const LAS float* sg = lds + st * STG;
            LAS float* ydst = YP + st * 8192 + lrow * 16 + kq;
            f32x4 w = *(const LAS f32x4*)(sg + 4 * kq), kv = *(const LAS f32x4*)(sg + 2048 + 4 * kq), kk = *(const LAS f32x4*)(sg + 4096 + 4 * kq);
            f32x4 bb = *(const LAS f32x4*)(sg + 6144 + 4 * kq), r = *(const LAS f32x4*)(sg + 8192 + 4 * kq);
            float v = sg[10240 + vrow] * vm;
#pragma unroll 8
            for (int s = 0; s < SC; ++s) {
                const int sn = (s + 1 < SC) ? s + 1 : s;
                const int o = sn * 64 + 4 * kq;
                const f32x4 nw = *(const LAS f32x4*)(sg + o), nkv = *(const LAS f32x4*)(sg + 2048 + o), nkk = *(const LAS f32x4*)(sg + 4096 + o);
                const f32x4 nbb = *(const LAS f32x4*)(sg + 6144 + o), nr = *(const LAS f32x4*)(sg + 8192 + o);
                const float nv = sg[10240 + sn * 16 + vrow] * vm;
                const f32x2 vv = {v, v};
                const f32x2 d2 = S01 * (f32x2){kk.x, kk.y} + S23 * (f32x2){kk.z, kk.w};
                const float sa = row16_sum(d2.x + d2.y);
                const f32x2 nsa = {-sa, -sa};
                S01 = (S01 * (f32x2){w.x, w.y} + vv * (f32x2){kv.x, kv.y}) + nsa * (f32x2){bb.x, bb.y};
                S23 = (S23 * (f32x2){w.z, w.w} + vv * (f32x2){kv.z, kv.w}) + nsa * (f32x2){bb.z, bb.w};
                const f32x2 y2 = S01 * (f32x2){r.x, r.y} + S23 * (f32x2){r.z, r.w};
                ydst[s * 256] = y2.x + y2.y;
                w = nw; kv = nkv; kk = nkk; bb = nbb; r = nr; v = nv;
            }
            __syncthreads();
        }
        if (seg == 0) *(f32x4*)(p.SMID + ((size_t)bh * 64 + 16 * jb + lrow) * 64 + 4 * kq) = (f32x4){S01.x, S01.y, S23.x, S23.y};
    }
    __syncthreads();
}

struct PostP { const float* Y; const bf16_t *R, *K, *V, *G; const float *r_k, *gn_g, *gn_b; bf16_t* O; const bf16_t* Q; const float* SMID; };
__device__ __forceinline__ void rwkv_post(const PostP& p, int blk, int nblk) {
    int tid_ = threadIdx.x; asm volatile("" : "+v"(tid_));
    const int lane = tid_ & 63, h = tid_ >> 6, col = lane & 15, quad = lane >> 4;
    const int ch0 = h * 64 + 4 * col;
    const f32x4 rk = *(const f32x4*)(p.r_k + ch0), gg = *(const f32x4*)(p.gn_g + ch0), gb = *(const f32x4*)(p.gn_b + ch0);
    bf16x8 Bf[4][2]; int bcur = -1;
    for (int tile = blk; tile < MTOK / 16; tile += nblk) {
        const int t0 = tile * 16, bq = t0 / SEQ, tpos = t0 % SEQ;
        f32x4 corr[4];
#pragma unroll
        for (int n = 0; n < 4; ++n) corr[n] = (f32x4){0.f, 0.f, 0.f, 0.f};
        if (tpos >= SEGT) {
            if (bq != bcur) { bcur = bq;
#pragma unroll
                for (int n = 0; n < 4; ++n) { const float* sr = p.SMID + ((size_t)(bq * 8 + h) * 64 + 4 * col + n) * 64 + 8 * quad;
#pragma unroll
                    for (int ks = 0; ks < 2; ++ks) { const f32x4 a = *(const f32x4*)(sr + 32 * ks), c4 = *(const f32x4*)(sr + 32 * ks + 4);
                        u32x4 w; w.x = pk2(a.x, a.y); w.y = pk2(a.z, a.w); w.z = pk2(c4.x, c4.y); w.w = pk2(c4.z, c4.w); Bf[n][ks] = __builtin_bit_cast(bf16x8, w); } } }
            const bf16_t* qrow = p.Q + ((size_t)bq * SEGT + (size_t)(tpos - SEGT) + col) * RW + h * 64 + 8 * quad;
            const bf16x8 A0 = *(const bf16x8*)qrow, A1 = *(const bf16x8*)(qrow + 32);
#pragma unroll
            for (int n = 0; n < 4; ++n) { const f32x4 a = __builtin_amdgcn_mfma_f32_16x16x32_bf16(A0, Bf[n][0], (f32x4){0.f, 0.f, 0.f, 0.f}, 0, 0, 0);
                corr[n] = __builtin_amdgcn_mfma_f32_16x16x32_bf16(A1, Bf[n][1], a, 0, 0, 0); }
        }
#pragma unroll
        for (int i = 0; i < 4; ++i) {
            const size_t o = (size_t)(t0 + 4 * quad + i) * RW + ch0;
            f32x4 y = *(const f32x4*)(p.Y + o);
            y.x += corr[0][i]; y.y += corr[1][i]; y.z += corr[2][i]; y.w += corr[3][i];
            const u32x2 rr = *(const u32x2*)(p.R + o), kk = *(const u32x2*)(p.K + o), vv = *(const u32x2*)(p.V + o), gq = *(const u32x2*)(p.G + o);
            const f32x4 r = {bflo(rr.x), bfhi(rr.x), bflo(rr.y), bfhi(rr.y)}, k = {bflo(kk.x), bfhi(kk.x), bflo(kk.y), bfhi(kk.y)};
            const f32x4 v = {bflo(vv.x), bfhi(vv.x), bflo(vv.y), bfhi(vv.y)}, g = {bflo(gq.x), bfhi(gq.x), bflo(gq.y), bfhi(gq.y)};
            const float mean = row16_sum((y.x + y.y) + (y.z + y.w)) * (1.f / 64.f);
            const f32x4 d = y - mean;
            const float var = row16_sum((d.x * d.x + d.y * d.y) + (d.z * d.z + d.w * d.w)) * (1.f / 64.f);
            const float rstd = __builtin_amdgcn_rsqf(var + 64e-5f);
            const f32x4 rkk = r * k * rk;
            const float bon = row16_sum((rkk.x + rkk.y) + (rkk.z + rkk.w));
            const f32x4 out = ((d * rstd) * gg + gb + v * bon) * g;
            u32x2 w; w.x = pk2(out.x, out.y); w.y = pk2(out.z, out.w);
            *(u32x2*)(p.O + o) = w;
        }
    }
}

template <int DH, bool BIAS>
__device__ __forceinline__ void attn_wave(const bf16_t* Qp, int ldq, const float* qgain, float qscale,
                                          const bf16_t* Kp, int ldk, const bf16_t* Vt, int ldv,
                                          int nchunks, int j0, int qoff, const LAS float* bias,
                                          bf16_t* Op, int ldo, int lane) {
    constexpr int NKS = DH / 32, NDT = DH / 16;
    const int fr = lane & 15, fq = lane >> 4;
    bf16x8 Qf[2][NKS];
#pragma unroll
    for (int qg = 0; qg < 2; ++qg) {
        float vals[NKS][8]; float ss = 0.f;
#pragma unroll
        for (int ks = 0; ks < NKS; ++ks) { const u32x4 raw = *(const u32x4*)(Qp + (size_t)(16 * qg + fr) * ldq + 32 * ks + 8 * fq);
            vals[ks][0] = bflo(raw.x); vals[ks][1] = bfhi(raw.x); vals[ks][2] = bflo(raw.y); vals[ks][3] = bfhi(raw.y);
            vals[ks][4] = bflo(raw.z); vals[ks][5] = bfhi(raw.z); vals[ks][6] = bflo(raw.w); vals[ks][7] = bfhi(raw.w);
#pragma unroll
            for (int j = 0; j < 8; ++j) ss += vals[ks][j] * vals[ks][j]; }
        ss += shx(ss, 16, lane); ss += shx(ss, 32, lane);
        const float sc = (1.0f / sqrtf(ss * (1.f / DH) + 1e-6f)) * qscale;
#pragma unroll
        for (int ks = 0; ks < NKS; ++ks) { const f32x4 g0 = *(const f32x4*)(qgain + 32 * ks + 8 * fq), g1 = *(const f32x4*)(qgain + 32 * ks + 8 * fq + 4);
            u32x4 w; w.x = pk2(vals[ks][0] * sc * g0.x, vals[ks][1] * sc * g0.y); w.y = pk2(vals[ks][2] * sc * g0.z, vals[ks][3] * sc * g0.w);
            w.z = pk2(vals[ks][4] * sc * g1.x, vals[ks][5] * sc * g1.y); w.w = pk2(vals[ks][6] * sc * g1.z, vals[ks][7] * sc * g1.w);
            Qf[qg][ks] = __builtin_bit_cast(bf16x8, w); }
    }
    f32x4 O[NDT][2];
#pragma unroll
    for (int dt = 0; dt < NDT; ++dt) { O[dt][0] = (f32x4){0.f, 0.f, 0.f, 0.f}; O[dt][1] = (f32x4){0.f, 0.f, 0.f, 0.f}; }
    float mrun[2] = {-1e30f, -1e30f}, lsum[2] = {0.f, 0.f};
    for (int ci = 0; ci < nchunks; ++ci) {
        const bf16_t* Kc = Kp + (size_t)ci * 64 * ldk; const bf16_t* Vc = Vt + ci * 64;
        f32x4 S[4][2];
#pragma unroll
        for (int kt = 0; kt < 4; ++kt) {
            bf16x8 Kf[NKS];
#pragma unroll
            for (int ks = 0; ks < NKS; ++ks) Kf[ks] = *(const bf16x8*)(Kc + (size_t)(32 * (kt >> 1) + 8 * (fr >> 2) + 4 * (kt & 1) + (fr & 3)) * ldk + 32 * ks + 8 * fq);
#pragma unroll
            for (int qg = 0; qg < 2; ++qg) { f32x4 a = (f32x4){0.f, 0.f, 0.f, 0.f};
#pragma unroll
                for (int ks = 0; ks < NKS; ++ks) a = __builtin_amdgcn_mfma_f32_16x16x32_bf16(Kf[ks], Qf[qg][ks], a, 0, 0, 0);
                S[kt][qg] = a; }
        }
        if (BIAS) {
            const int j = j0 + ci;
            if (j <= 5) { const float bc = bias[NREL - 1];
#pragma unroll
                for (int kt = 0; kt < 4; ++kt)
#pragma unroll
                    for (int qg = 0; qg < 2; ++qg) S[kt][qg] = S[kt][qg] + bc;
            } else {
                const int dbase = (8 - j) * 64 + qoff + fr - 8 * fq + 63;
#pragma unroll
                for (int kt = 0; kt < 4; ++kt)
#pragma unroll
                    for (int qg = 0; qg < 2; ++qg)
#pragma unroll
                        for (int i = 0; i < 4; ++i) { int idx = dbase + 16 * qg - 32 * (kt >> 1) - 4 * (kt & 1) - i; idx = idx < 0 ? 0 : (idx > NREL - 1 ? NREL - 1 : idx); S[kt][qg][i] += bias[idx]; }
            }
        }
        bf16x8 Pf[2][2];
#pragma unroll
        for (int qg = 0; qg < 2; ++qg) {
            float mx = -1e30f;
#pragma unroll
            for (int kt = 0; kt < 4; ++kt)
#pragma unroll
                for (int i = 0; i < 4; ++i) mx = fmaxf(mx, S[kt][qg][i]);
            mx = fmaxf(mx, shx(mx, 16, lane)); mx = fmaxf(mx, shx(mx, 32, lane));
            const float mn = fmaxf(mrun[qg], mx), alpha = fexp2(mrun[qg] - mn); mrun[qg] = mn;
            float ps = 0.f;
#pragma unroll
            for (int kt = 0; kt < 4; ++kt)
#pragma unroll
                for (int i = 0; i < 4; ++i) { const float pv = fexp2(S[kt][qg][i] - mn); S[kt][qg][i] = pv; ps += pv; }
            lsum[qg] = lsum[qg] * alpha + ps;
#pragma unroll
            for (int dt = 0; dt < NDT; ++dt) O[dt][qg] = O[dt][qg] * alpha;
#pragma unroll
            for (int s = 0; s < 2; ++s) { u32x4 w; w.x = pk2(S[2 * s][qg][0], S[2 * s][qg][1]); w.y = pk2(S[2 * s][qg][2], S[2 * s][qg][3]);
                w.z = pk2(S[2 * s + 1][qg][0], S[2 * s + 1][qg][1]); w.w = pk2(S[2 * s + 1][qg][2], S[2 * s + 1][qg][3]); Pf[qg][s] = __builtin_bit_cast(bf16x8, w); }
        }
#pragma unroll
        for (int dt = 0; dt < NDT; ++dt)
#pragma unroll
            for (int s = 0; s < 2; ++s) { const bf16x8 Vf = *(const bf16x8*)(Vc + (size_t)(16 * dt + fr) * ldv + 32 * s + 8 * fq);
#pragma unroll
                for (int qg = 0; qg < 2; ++qg) O[dt][qg] = __builtin_amdgcn_mfma_f32_16x16x32_bf16(Vf, Pf[qg][s], O[dt][qg], 0, 0, 0); }
    }
#pragma unroll
    for (int qg = 0; qg < 2; ++qg) {
        float l = lsum[qg]; l += shx(l, 16, lane); l += shx(l, 32, lane);
        const float inv = 1.0f / l;
#pragma unroll
        for (int dt = 0; dt < NDT; ++dt) { const f32x4 o = O[dt][qg] * inv; u32x2 w; w.x = pk2(o[0], o[1]); w.y = pk2(o[2], o[3]);
            *(u32x2*)(Op + (size_t)(16 * qg + fr) * ldo + 16 * dt + 4 * fq) = w; }
    }
}

struct AttnP { const bf16_t *P, *KN, *VT, *MK, *MVT; const float *aqn, *mqn, *rel; bf16_t *Yatt, *Ymem; };
__device__ __forceinline__ void attn_unit(LAS float* wlds, const AttnP& p, int u, int lane_) {
    int lane = lane_; asm volatile("" : "+v"(lane));
    if (u < 4096) {
        const int qh = u & 1, h = (u >> 1) & 7, c = (u >> 4) & 127, b = u >> 11;
#pragma unroll
        for (int i = 0; i < 3; ++i) wlds[lane + 64 * i] = p.rel[h * NREL + lane + 64 * i] * LOG2E;
        LDS_WAIT(); asm volatile("" ::: "memory");
        const int js = (8 - c) > 0 ? (8 - c) : 0, kc0 = c - 8 + js;
        const size_t q0 = (size_t)b * SEQ + c * 64 + 32 * qh;
        attn_wave<64, true>(p.P + q0 * DIN + COL_AQ + h * 64, DIN, p.aqn, 0.125f * LOG2E,
                            p.KN + ((size_t)b * SEQ + kc0 * 64) * RW + h * 64, RW,
                            p.VT + ((size_t)(b * 8 + h) * 64) * SEQ + kc0 * 64, SEQ,
                            9 - js, js, 32 * qh, wlds, p.Yatt + q0 * RW + h * 64, RW, lane);
        LDS_WAIT(); asm volatile("" ::: "memory");
    } else {
        const int mu = u - 4096, hm = mu & 3, tile = mu >> 2, b = tile >> 8;
        const size_t q0 = (size_t)tile * 32;
        attn_wave<128, false>(p.P + q0 * DIN + COL_MQ + hm * 128, DIN, p.mqn, 0.08838834764831845f * LOG2E,
                              p.MK + ((size_t)b * 256) * 512 + hm * 128, 512,
                              p.MVT + ((size_t)(b * 4 + hm) * 128) * 256, 256,
                              4, 0, 0, wlds, p.Ymem + q0 * RW + hm * 128, RW, lane);
    }
}


#define XB_TMO      128
#define XB_XCNT(j)  (256  + 64 * (j))
#define XB_XSUB(j)  (1280 + 64 * (j))
#define XB_XGEN(j)  (2304 + 64 * (j))
#define XB_TOP      3328
#define XB_TOPGEN   3392
#define XCD_BAR_WORDS 3456
#define XB_SPIN_CAP (1u << 18)
__device__ __forceinline__ unsigned xb_ld(unsigned* p)              { return __hip_atomic_load(p, __ATOMIC_RELAXED, __HIP_MEMORY_SCOPE_AGENT); }
__device__ __forceinline__ unsigned xb_add(unsigned* p, unsigned v) { return __hip_atomic_fetch_add(p, v, __ATOMIC_RELAXED, __HIP_MEMORY_SCOPE_AGENT); }
__device__ __forceinline__ unsigned xb_xcc_id() { return (unsigned)__builtin_amdgcn_s_getreg((3 << 11) | 20) & 0xFu; }
#define XB_SPIN(cond, bar) do { unsigned _sp = 0; while (cond) { __builtin_amdgcn_s_sleep(1); \
    if ((++_sp & 255u) == 0u) { if (xb_ld(&(bar)[XB_TMO])) break; if (_sp > XB_SPIN_CAP) { atomicAdd(&(bar)[XB_TMO], 1u); break; } } } } while (0)
struct XcdBarrier { unsigned* bar; unsigned x; volatile LAS unsigned* st; };
__device__ __forceinline__ XcdBarrier xcd_barrier_post(unsigned* bar, volatile LAS unsigned* st) {
    XcdBarrier b; b.bar = bar; b.x = xb_xcc_id(); b.st = st;
    if (threadIdx.x == 0) (void)xb_add(&bar[XB_XCNT(b.x)], 1u);
    return b;
}
__device__ __forceinline__ void xcd_barrier_complete(unsigned* bar, unsigned x, unsigned& nloc, unsigned& nx) {
    const unsigned G = gridDim.x * gridDim.y * gridDim.z;
    unsigned sum, cnt, mine, sp = 0u;
    for (;;) {
        sum = 0u; cnt = 0u; mine = 0u;
#pragma unroll
        for (unsigned j = 0; j < 16; ++j) { const unsigned c = xb_ld(&bar[XB_XCNT(j)]); sum += c; cnt += (c > 0u) ? 1u : 0u; mine = (j == x) ? c : mine; }
        if (sum == G) break;
        __builtin_amdgcn_s_sleep(1);
        if ((++sp & 255u) == 0u) { if (xb_ld(&bar[XB_TMO])) break; if (sp > XB_SPIN_CAP) { atomicAdd(&bar[XB_TMO], 1u); break; } }
    }
    nloc = mine > 0u ? mine : 1u; nx = cnt > 0u ? cnt : 1u;
}
__device__ __forceinline__ void xcd_barrier(unsigned* bar, volatile LAS unsigned* st) {
    asm volatile("s_waitcnt vmcnt(0)" ::: "memory");
    __syncthreads();
    if (threadIdx.x == 0) {
        const unsigned x = xb_xcc_id();
        __builtin_amdgcn_s_waitcnt(0);
        unsigned nloc = st[0], nx = st[1];
        if (nloc == 0u) { xcd_barrier_complete(bar, x, nloc, nx); st[0] = nloc; st[1] = nx; }
        const unsigned old = xb_add(&bar[XB_XSUB(x)], 1u);
        const unsigned gen = old / nloc;
        if (old + 1u == (gen + 1u) * nloc) {
            __builtin_amdgcn_fence(__ATOMIC_RELEASE, "agent");
            asm volatile("s_waitcnt vmcnt(0)" ::: "memory");
            const unsigned og = xb_add(&bar[XB_TOP], 1u);
            const unsigned tg = og / nx;
            if (og + 1u == (tg + 1u) * nx) xb_add(&bar[XB_TOPGEN], 1u);
            else XB_SPIN(xb_ld(&bar[XB_TOPGEN]) == tg, bar);
            __builtin_amdgcn_fence(__ATOMIC_ACQUIRE, "agent");
            xb_add(&bar[XB_XGEN(x)], 1u);
            asm volatile("s_waitcnt vmcnt(0)" ::: "memory");
        } else {
            XB_SPIN(xb_ld(&bar[XB_XGEN(x)]) == gen, bar);
            __builtin_amdgcn_fence(__ATOMIC_ACQUIRE, "agent");
            asm volatile("s_waitcnt vmcnt(0)" ::: "memory");
        }
    }
    __syncthreads();
}


__device__ __forceinline__ void dbg_dump(float* X, const unsigned char* wsb, size_t off_f32, size_t off_a, size_t off_b, int G, int bx) {
    const size_t n = (size_t)MTOK * 512;
    int t_ = threadIdx.x; asm volatile("" : "+v"(t_));
    for (size_t i = (size_t)bx * 512 + t_; i < n / 2; i += (size_t)G * 512) {
        const unsigned wa = off_a ? __hip_atomic_load((unsigned*)(wsb + off_a) + i, __ATOMIC_RELAXED, __HIP_MEMORY_SCOPE_AGENT) : 0u;
        const unsigned wb = off_b ? __hip_atomic_load((unsigned*)(wsb + off_b) + i, __ATOMIC_RELAXED, __HIP_MEMORY_SCOPE_AGENT) : 0u;
        X[2 * i] = bflo(wa) + bflo(wb); X[2 * i + 1] = bfhi(wa) + bfhi(wb);
        X[n + 2 * i] = 0.f; X[n + 2 * i + 1] = 0.f;
    }
}
__device__ __forceinline__ const float* tabp(const LAS unsigned long long* tab, int i) {
    unsigned b = (unsigned)(size_t)tab; asm volatile("" : "+v"(b));
    const unsigned long long v = ((const LAS unsigned long long*)(size_t)b)[i];
    const unsigned lo = __builtin_amdgcn_readfirstlane((unsigned)v), hi = __builtin_amdgcn_readfirstlane((unsigned)(v >> 32));
    const __attribute__((address_space(1))) float* g = (const __attribute__((address_space(1))) float*)(((unsigned long long)hi << 32) | lo);
    return (const float*)g;
}
#define IN(i) tabp(ptab, (i))
#define FRESH_LANE() ({ int _t = threadIdx.x; asm volatile("" : "+v"(_t)); _t & 63; })
#define WSP ((unsigned char*)tabp(ptab, 38))
#define WSP_EARLY ((unsigned char*)tabp(ptab, 38))
#define XOUT ((float*)tabp(ptab, 37))
__global__ void __launch_bounds__(512, 2) mega_fwd(Args a_unused) {
    extern __shared__ __attribute__((aligned(16))) unsigned char lds_raw[];
    cg::grid_group grid = cg::this_grid();
    LAS unsigned char* lds = (LAS unsigned char*)lds_raw;
    const int tid = threadIdx.x, wave = __builtin_amdgcn_readfirstlane(tid >> 6);
    LAS unsigned long long* ptab = (LAS unsigned long long*)(lds + PTAB_OFF);
    { const unsigned long long* ka = (const unsigned long long*)__builtin_amdgcn_kernarg_segment_ptr(); if (tid < 39) ptab[tid] = ka[tid]; }
    volatile LAS unsigned* bst = (volatile LAS unsigned*)(lds + PTAB_OFF + 512);
    if (tid < 2) bst[tid] = 0u;
    __syncthreads();
    grid.sync();
    (void)xcd_barrier_post((unsigned*)WSP_EARLY, bst);
#define GSYNC() xcd_barrier((unsigned*)WSP, bst)
    const int G0 = gridDim.x, bx0 = blockIdx.x;
    LAS float* wscr = (LAS float*)(lds + wave * 16384);
#define W1A ((bf16_t*)(WSP + WS_W1A))
#define W1B ((bf16_t*)(WSP + WS_W1B))
#define WP ((bf16_t*)(WSP + WS_WP))
#define WBR ((bf16_t*)(WSP + WS_WBR))
#define WO ((bf16_t*)(WSP + WS_WO))
#define HN ((bf16_t*)(WSP + WS_HN))
#define PROJ ((bf16_t*)(WSP + WS_PROJ))
#define ACT PROJ
#define GATES ((bf16_t*)(WSP + WS_GATES))
#define VRA ((float*)(WSP + WS_VRA))
#define X XOUT
#define ws WSP

    {
        const int gw = bx0 * 8 + wave, NGW = G0 * 8, lane = FRESH_LANE();
        int base = 0;
        for (int l = 0; l < 4; ++l) tr_job(IN(25) + (size_t)l * DM * DM, (bf16_t*)(ws + WS_WMKV) + (size_t)l * DM * DM, DM, DM, 0, 0, base, wscr, gw, NGW, lane);
        for (int l = 0; l < 4; ++l) rms_rows(IN(1), nullptr, IN(24) + l * DM, (bf16_t*)(ws + WS_MEMN) + (size_t)l * 512 * DM, 512, gw, NGW, lane);
    }
    for (int l_ = 0; l_ < DEPTH; ++l_) {
        int l = l_, G = G0, bx = bx0; asm volatile("" : "+s"(l), "+s"(G), "+s"(bx));
        const int gw = bx * 8 + wave, NGW = G * 8;
        {
            const int lane = FRESH_LANE();
            int base = 0;
            tr_job(IN(3) + (size_t)l * DM * 2 * DFF, W1A, DM, 2 * DFF, 1, 0, base, wscr, gw, NGW, lane);
            tr_job(IN(4) + (size_t)l * DFF * DM, W1B, DFF, DM, 0, 0, base, wscr, gw, NGW, lane);
            tr_job(IN(6) + (size_t)l * DM * DIN, WP, DM, DIN, 0, 0, base, wscr, gw, NGW, lane);
            tr_job(IN(31) + (size_t)l * DM * 3072, WP, DM, 3072, 0, DIN, base, wscr, gw, NGW, lane);
            tr_job(IN(29) + (size_t)l * RW * DM, WBR, RW, DM, 0, 0, base, wscr, gw, NGW, lane);
            tr_job(IN(30) + (size_t)l * RW * DM, WBR, RW, DM, 0, 1024, base, wscr, gw, NGW, lane);
            tr_job(IN(28) + (size_t)l * RW * DM, WBR, RW, DM, 0, 2048, base, wscr, gw, NGW, lane);
            tr_job(IN(33) + (size_t)l * DM * DM, WO, DM, DM, 0, 0, base, wscr, gw, NGW, lane);
            if (l > 0) tr_job(IN(19) + (size_t)(l - 1) * DM * 32, WP, DM, 32, 0, DIN + 3072, base, wscr, gw, NGW, lane);
            if (l == 0) rms_rows(IN(0), X, IN(2), HN, MTOK, gw, NGW, lane);
            else rms_rows(X, nullptr, IN(2) + l * DM, HN, MTOK, gw, NGW, lane);
        }
        GSYNC();
        if (STOP_AT == 1 && l == STOP_LAYER) return;
        if (l == 0) {
            pg8::Gemm g{(const bf16_t*)(ws + WS_MEMN), (const bf16_t*)(ws + WS_WMKV), (size_t)512 * DM * 2, (size_t)DM * DM * 2, 512, DM, DM};
            pg8::ZOrder S{G, bx};
            pg8::EpiPlain E{(bf16_t*)(ws + WS_MKVRAW), DM, (size_t)512 * DM};
            pg8::gemm_phase<pg8::EpiPlain, pg8::ZOrder>(lds, g, S, E);
            GSYNC();
        if (STOP_AT == 2 && l == STOP_LAYER) return;
            const int lane = FRESH_LANE();
            for (int r = gw; r < 4 * 512; r += NGW) { const int ll = r >> 9, row = r & 511;
                mem_post_row((const bf16_t*)(ws + WS_MKVRAW) + (size_t)ll * 512 * DM, (bf16_t*)(ws + WS_MK) + (size_t)ll * 512 * 512, (bf16_t*)(ws + WS_MVT) + (size_t)ll * 8 * 128 * 256, IN(27) + ll * 128, row, lane); }
        }
        { pg8::Gemm g{HN, W1A, 0, 0, MTOK, 2 * DFF, DM}; pg8::StaticOrder S; S.init(MTOK, 2 * DFF, G, bx); pg8::EpiSwiglu E{ACT};
          pg8::gemm_phase<pg8::EpiSwiglu, pg8::StaticOrder>(lds, g, S, E); }
        GSYNC();
        if (STOP_AT == 3 && l == STOP_LAYER) return;
        { pg8::Gemm g{ACT, W1B, 0, 0, MTOK, DM, DFF}; pg8::StaticOrder S; S.init(MTOK, DM, G, bx); pg8::EpiResid E{X, 0.5f};
          pg8::gemm_phase<pg8::EpiResid, pg8::StaticOrder>(lds, g, S, E); }
        GSYNC();
        if (STOP_AT == 4 && l == STOP_LAYER) return;
        {
            const int lane = FRESH_LANE();
            rms_rows(X, nullptr, IN(5) + l * DM, HN, MTOK, gw, NGW, lane);
            int base = 0;
            tr_job(IN(35) + (size_t)l * DM * 2 * DFF, W1A, DM, 2 * DFF, 1, 0, base, wscr, gw, NGW, lane);
            tr_job(IN(36) + (size_t)l * DFF * DM, W1B, DFF, DM, 0, 0, base, wscr, gw, NGW, lane);
        }
        GSYNC();
        if (STOP_AT == 5 && l == STOP_LAYER) return;
        { const int N = (l > 0) ? 7168 : 6912;
          pg8::Gemm g{HN, WP, 0, 0, MTOK, N, DM}; pg8::StaticOrder S; S.init(MTOK, N, G, bx); pg8::EpiProj E{PROJ, GATES, VRA, IN(32) + l * 3072};
          pg8::gemm_phase<pg8::EpiProj, pg8::StaticOrder>(lds, g, S, E); }
        GSYNC();
        if (STOP_AT == 6 && l == STOP_LAYER) { dbg_dump(X, ws, 0, DBG_A, DBG_B, G, bx); return; }
        {
#define PREP_SETUP() \
            const int li = l > 0 ? l - 1 : 0; \
            PrepP p; \
            p.P = PROJ; p.VRAp = VRA; p.mu = IN(7) + l * RWKV_IN; p.w0 = IN(8) + l * RW; p.decay_b = IN(9) + (size_t)l * 64 * RW; p.a0 = IN(10) + l * RW; \
            p.iclr_b = IN(11) + (size_t)l * 64 * RW; p.gate_b = IN(12) + (size_t)l * 128 * RW; p.k_k = IN(13) + l * RW; p.k_a = IN(14) + l * RW; \
            p.v0 = IN(18) + li * RW; p.vres_b = IN(20) + (size_t)li * 32 * RW; p.akn = IN(22) + l * 64; \
            p.R = (bf16_t*)(ws + WS_R); p.K = (bf16_t*)(ws + WS_K); p.V = (bf16_t*)(ws + WS_V); p.G = (bf16_t*)(ws + WS_G); p.KK = (bf16_t*)(ws + WS_KK); \
            p.BB = (bf16_t*)(ws + WS_BB); p.EW = (bf16_t*)(ws + WS_EW); p.VF = (bf16_t*)(ws + WS_VFIRST); p.KN = (bf16_t*)(ws + WS_KN); p.VT = (bf16_t*)(ws + WS_VT); \
            p.LIN = (bf16_t*)(ws + WS_LIN); p.LBT = (bf16_t*)(ws + WS_LBT); p.LOA = (const bf16_t*)(ws + WS_LOA); p.LOB = (const bf16_t*)(ws + WS_LOB); \
            p.use_vres = l > 0; \

            { PREP_SETUP()
            { int t_ = threadIdx.x; asm volatile("" : "+v"(t_)); lora_bt_build(p, bx * 512 + t_, G * 512); }
            prepA(p, bx, G); }
            GSYNC();
            { pg8::Gemm g{(const bf16_t*)(ws + WS_LIN), (const bf16_t*)(ws + WS_LBT), 0, 0, MTOK, 2048, 384}; pg8::StaticOrder S; S.init(MTOK, 2048, G, bx);
              pg8::EpiSplit2 E{(bf16_t*)(ws + WS_LOA), (bf16_t*)(ws + WS_LOB)};
              pg8::gemm_phase<pg8::EpiSplit2, pg8::StaticOrder>(lds, g, S, E); }
            GSYNC();
            { PREP_SETUP()
            prepB(p, bx, G); }
        }
        GSYNC();
        if (STOP_AT == 7 && l == STOP_LAYER) return;
        {
            AttnP ap{PROJ, (const bf16_t*)(ws + WS_KN), (const bf16_t*)(ws + WS_VT), (const bf16_t*)(ws + WS_MK) + (size_t)l * 512 * 512, (const bf16_t*)(ws + WS_MVT) + (size_t)l * 8 * 128 * 256,
                     IN(21) + l * 64, IN(26) + l * 128, IN(23) + (size_t)l * 8 * NREL, (bf16_t*)(ws + WS_YATT), (bf16_t*)(ws + WS_YMEM)};
            const int lane = FRESH_LANE();
            if (bx < 192) {
                attn_unit(wscr, ap, bx * 8 + wave, lane);
                __syncthreads();
                ScanP sp{(const bf16_t*)(ws + WS_R), (const bf16_t*)(ws + WS_K), (const bf16_t*)(ws + WS_V), (const bf16_t*)(ws + WS_KK), (const bf16_t*)(ws + WS_BB), (const bf16_t*)(ws + WS_EW), (float*)(ws + WS_YRAW),
                         (bf16_t*)(ws + WS_SQ), (float*)(ws + WS_SMID)};
                scan_block(lds, sp, bx);
            } else {
                const int NW2 = (G - 192) * 8;
                for (int u = 1536 + (bx - 192) * 8 + wave; u < 6144; u += NW2) attn_unit(wscr, ap, u, lane);
            }
        }
        GSYNC();
        if (STOP_AT == 8 && l == STOP_LAYER) { dbg_dump(X, ws, WS_YRAW, WS_YATT, WS_YMEM, G, bx); return; }
        {
            PostP pp{(const float*)(ws + WS_YRAW), (const bf16_t*)(ws + WS_R), (const bf16_t*)(ws + WS_K), (const bf16_t*)(ws + WS_V), (const bf16_t*)(ws + WS_G),
                     IN(15) + l * RW, IN(16) + l * RW, IN(17) + l * RW, (bf16_t*)(ws + WS_YRWKV), (const bf16_t*)(ws + WS_SQ), (const float*)(ws + WS_SMID)};
            rwkv_post(pp, bx, G);
        }
        GSYNC();
        if (STOP_AT == 9 && l == STOP_LAYER) { dbg_dump(X, ws, 0, WS_YRWKV, 0, G, bx); return; }
        { pg8::Gemm g{(const bf16_t*)(ws + WS_YATT), WBR, (size_t)16 * MiB, (size_t)DM * RW * 2, MTOK, DM, RW}; pg8::StaticOrder S; S.init(MTOK, DM, G, bx, 3);
          pg8::EpiMerge E{(bf16_t*)(ws + WS_MERGEDF), (bf16_t*)(ws + WS_MERGEDB), GATES};
          pg8::gemm_phase<pg8::EpiMerge, pg8::StaticOrder>(lds, g, S, E); }
        GSYNC();
        if (STOP_AT == 10 && l == STOP_LAYER) { dbg_dump(X, ws, 0, WS_MERGEDB, WS_MERGEDB + 16 * MiB, G, bx); return; }
        { pg8::Gemm g{(const bf16_t*)(ws + WS_MERGEDB), WO, 0, 0, MTOK, DM, DM}; pg8::StaticOrder S; S.init(MTOK, DM, G, bx); pg8::EpiResid E{X, 1.0f};
          pg8::gemm_phase<pg8::EpiResid, pg8::StaticOrder>(lds, g, S, E); }
        GSYNC();
        if (STOP_AT == 11 && l == STOP_LAYER) return;
        { const int lane = FRESH_LANE(); rms_rows(X, nullptr, IN(34) + l * DM, HN, MTOK, gw, NGW, lane); }
        GSYNC();
        if (STOP_AT == 12 && l == STOP_LAYER) return;
        { pg8::Gemm g{HN, W1A, 0, 0, MTOK, 2 * DFF, DM}; pg8::StaticOrder S; S.init(MTOK, 2 * DFF, G, bx); pg8::EpiSwiglu E{ACT};
          pg8::gemm_phase<pg8::EpiSwiglu, pg8::StaticOrder>(lds, g, S, E); }
        GSYNC();
        if (STOP_AT == 13 && l == STOP_LAYER) return;
        { pg8::Gemm g{ACT, W1B, 0, 0, MTOK, DM, DFF}; pg8::StaticOrder S; S.init(MTOK, DM, G, bx); pg8::EpiResid E{X, 0.5f};
          pg8::gemm_phase<pg8::EpiResid, pg8::StaticOrder>(lds, g, S, E); }
        GSYNC();
        if (STOP_AT == 14 && l == STOP_LAYER) return;
    }
}

#undef W1A
#undef W1B
#undef WP
#undef WBR
#undef WO
#undef HN
#undef PROJ
#undef ACT
#undef GATES
#undef VRA
#undef X
#undef ws
#undef IN
extern "C" void kernel_launch(void* const* d_in, const int* in_sizes, int n_in, void* d_out, int out_size, void* d_ws, size_t ws_size, hipStream_t stream) {
    static int grid = 0;
    if (grid == 0) {
        if (n_in != 37 || ws_size < WS_END) { fprintf(stderr, "kernel_launch: unexpected n_in %d or ws_size %zu (< %zu)\n", n_in, ws_size, (size_t)WS_END); }
        int dev = 0, cus = 0, per_cu = 0;
        (void)hipGetDevice(&dev);
        (void)hipDeviceGetAttribute(&cus, hipDeviceAttributeMultiprocessorCount, dev);
        (void)hipFuncSetAttribute((const void*)mega_fwd, hipFuncAttributeMaxDynamicSharedMemorySize, LDS_BYTES);
        (void)hipOccupancyMaxActiveBlocksPerMultiprocessor(&per_cu, (const void*)mega_fwd, 512, LDS_BYTES);
        if (per_cu < 1) per_cu = 1;
        grid = cus * per_cu;
        fprintf(stderr, "kernel_launch: cus %d per_cu %d grid %d\n", cus, per_cu, grid);
    }
    if (ws_size < WS_END) return;
    (void)hipMemsetAsync(d_ws, 0, 65536, stream);
    Args a{};
    for (int i = 0; i < 37; ++i) a.in[i] = (const float*)d_in[i];
    a.out = (float*)d_out; a.ws = (unsigned char*)d_ws;
    void* args[] = {&a};
    hipError_t e = hipLaunchCooperativeKernel((const void*)mega_fwd, dim3(grid), dim3(512), args, LDS_BYTES, stream);
    if (e != hipSuccess) fprintf(stderr, "cooperative launch failed: %s (grid %d)\n", hipGetErrorString(e), grid);
}
```
